# Optimizing an MI355X kernel written in HIP

```python
import math
import jax, jax.numpy as jnp
from jax import lax
import numpy as np

D_MODEL = 2048
BATCH = 2
SEQ = 8192
DEPTH = 2

HEAD_DIM = 128
EPS = 1e-6
NEG = -1e30
N_EVEN = (DEPTH + 1) // 2
N_ODD = DEPTH // 2

A_HEADS = 8
A_PATTERNS = ((128, 1), (512, 4), (2048, 16))
B_HEADS = 8
Q_LORA = 512
KV_LORA = 256
QK_NOPE = 128
QK_ROPE = 64
V_DIM = 128
ROPE_THETA = 10000.0
C_HEADS = 16
MOBA_BLOCK = 256
MOBA_TOPK = 3
MOBA_Q_CHUNK = 16
Q_BLOCK = 128
N_EXPERTS = 16
N_GROUPS = 4
EXPERTS_PER_GROUP = N_EXPERTS // N_GROUPS
TOP_K = 2
EXPERT_FF = 512

A_QKV = 3 * A_HEADS * HEAD_DIM
EVEN_IN = A_QKV + Q_LORA + KV_LORA + QK_ROPE
EVEN_MIX = A_HEADS * HEAD_DIM + B_HEADS * V_DIM
ODD_MIX = C_HEADS * HEAD_DIM

kernel_name = 'hybrid_dilated_mla_moba_grouped_moe'


def rmsnorm(x, g):
    xf = x.astype(jnp.float32)
    y = xf * lax.rsqrt(jnp.mean(xf * xf, axis=-1, keepdims=True) + EPS)
    return (y * g.astype(jnp.float32)).astype(x.dtype)


def alibi_slopes(n):
    return 2.0 ** (-8.0 * jnp.arange(1, n + 1, dtype=jnp.float32) / n)


def rope(x, pos):
    r = x.shape[-1]
    inv = ROPE_THETA ** (-jnp.arange(0, r, 2, dtype=jnp.float32) / r)
    ang = pos.astype(jnp.float32)[:, None] * inv[None, :]
    cos = jnp.cos(ang)[None, :, None, :]
    sin = jnp.sin(ang)[None, :, None, :]
    x1, x2 = x[..., : r // 2], x[..., r // 2:]
    return jnp.concatenate([x1 * cos - x2 * sin, x1 * sin + x2 * cos], axis=-1)


def _dilated_partials(q, k, v, slopes, dil, band):
    B, S, H, Dh = q.shape
    L = S // dil
    nb = -(-L // band)
    Lp = nb * band

    def to_blocks(t):
        t = t.reshape(B, L, dil, H, Dh).transpose(0, 2, 1, 3, 4).reshape(B * dil, L, H, Dh)
        t = jnp.pad(t, ((0, 0), (0, Lp - L), (0, 0), (0, 0)))
        return t.reshape(B * dil, nb, band, H, Dh)

    qs, ks, vs = to_blocks(q), to_blocks(k), to_blocks(v)

    def with_prev(t):
        prev = jnp.pad(t, ((0, 0), (1, 0), (0, 0), (0, 0), (0, 0)))[:, :-1]
        return jnp.concatenate([prev, t], axis=2)

    kk, vv = with_prev(ks), with_prev(vs)
    qpos = jnp.arange(Lp).reshape(nb, band)
    kpos = qpos[:, :1] - band + jnp.arange(2 * band)[None, :]
    dist = qpos[:, :, None] - kpos[:, None, :]
    valid = (dist >= 0) & (dist <= band) & (kpos[:, None, :] >= 0)
    bias = -slopes[None, :, None, None] * (dist * dil).astype(jnp.float32)[:, None]
    s = jnp.einsum('xnqhd,xnkhd->xnhqk', qs, kk) * (HEAD_DIM ** -0.5)
    s = jnp.where(valid[:, None], s + bias, NEG)
    m = jnp.max(s, axis=-1)
    p = jnp.exp(s - m[..., None])
    l = jnp.sum(p, axis=-1)
    acc = jnp.einsum('xnhqk,xnkhd->xnqhd', p, vv)

    def back(t):
        t = t.reshape((B * dil, Lp) + t.shape[3:])[:, :L]
        t = t.reshape((B, dil, L) + t.shape[2:])
        return jnp.swapaxes(t, 1, 2).reshape((B, S) + t.shape[3:])

    return back(jnp.swapaxes(m, 2, 3)), back(jnp.swapaxes(l, 2, 3)), back(acc)


def dilated_attention(q, k, v, slopes):
    parts = [_dilated_partials(q, k, v, slopes, d, w // d) for (w, d) in A_PATTERNS]
    m_all = parts[0][0]
    for m_i, _, _ in parts[1:]:
        m_all = jnp.maximum(m_all, m_i)
    num = 0.0
    den = 0.0
    for m_i, l_i, acc_i in parts:
        w_i = jnp.exp(m_i - m_all)
        num = num + w_i[..., None] * acc_i
        den = den + w_i * l_i
    return num / den[..., None]


def causal_dense_attention(q, k, v):
    B, S, H, Dq = q.shape
    nqb = S // Q_BLOCK
    qb = q.reshape(B, nqb, Q_BLOCK, H, Dq).transpose(1, 0, 2, 3, 4)
    kpos = jnp.arange(S)
    scale = Dq ** -0.5

    def one(args):
        qi, i = args
        s = jnp.einsum('bqhd,bkhd->bhqk', qi, k) * scale
        qpos = i * Q_BLOCK + jnp.arange(Q_BLOCK)
        s = jnp.where(kpos[None, :] <= qpos[:, None], s, NEG)
        p = jax.nn.softmax(s, axis=-1)
        return jnp.einsum('bhqk,bkhd->bqhd', p, v)

    out = lax.map(one, (qb, jnp.arange(nqb)))
    return out.transpose(1, 0, 2, 3, 4).reshape(B, S, H, v.shape[-1])


def moba_attention(q, k, v, slopes):
    B, S, H, Dh = q.shape
    MB = MOBA_BLOCK
    nblk = -(-S // MB)
    Sp = nblk * MB
    pad = ((0, 0), (0, Sp - S), (0, 0), (0, 0))
    q, k, v = jnp.pad(q, pad), jnp.pad(k, pad), jnp.pad(v, pad)
    scale = Dh ** -0.5
    kb = k.reshape(B, nblk, MB, H, Dh)
    vb = v.reshape(B, nblk, MB, H, Dh)
    qblk = jnp.arange(Sp) // MB

    kmean = jnp.mean(kb, axis=2)
    gate = jnp.einsum('bshd,bjhd->bshj', q, kmean)
    past = jnp.arange(nblk)[None, :] < qblk[:, None]
    gate = jnp.where(past[None, :, None, :], gate, NEG)
    k_sel = min(MOBA_TOPK, nblk)
    _, sel = lax.top_k(gate, k_sel)

    qb = q.reshape(B, nblk, MB, H, Dh)
    i = jnp.arange(MB)
    dist_own = (i[:, None] - i[None, :])
    s_own = jnp.einsum('bnqhd,bnkhd->bnhqk', qb, kb) * scale
    s_own = jnp.where(dist_own >= 0, s_own - slopes[:, None, None] * dist_own.astype(jnp.float32), NEG)
    m_own = jnp.max(s_own, axis=-1)
    p_own = jnp.exp(s_own - m_own[..., None])
    l_own = jnp.sum(p_own, axis=-1)
    acc_own = jnp.einsum('bnhqk,bnkhd->bnqhd', p_own, vb).reshape(B, Sp, H, Dh)
    m_own = jnp.swapaxes(m_own, 2, 3).reshape(B, Sp, H)
    l_own = jnp.swapaxes(l_own, 2, 3).reshape(B, Sp, H)

    kh = kb.transpose(0, 3, 1, 2, 4)
    vh = vb.transpose(0, 3, 1, 2, 4)
    QC = MOBA_Q_CHUNK
    nc = Sp // QC
    qc = q.reshape(B, nc, QC, H, Dh).transpose(1, 0, 2, 3, 4)
    selc = sel.reshape(B, nc, QC, H, k_sel).transpose(1, 0, 2, 3, 4)
    bi = jnp.arange(B)[:, None, None, None]
    hi = jnp.arange(H)[None, None, :, None]

    def chunk(args):
        qi, si, c = args
        kg = kh[bi, hi, si]
        vg = vh[bi, hi, si]
        s = jnp.einsum('bqhd,bqhjkd->bqhjk', qi, kg) * scale
        qpos = c * QC + jnp.arange(QC)
        kpos = si[..., None] * MB + jnp.arange(MB)
        dist = (qpos[None, :, None, None, None] - kpos).astype(jnp.float32)
        slot_ok = jnp.arange(k_sel)[None, :] < (qpos // MB)[:, None]
        s = jnp.where(slot_ok[None, :, None, :, None], s - slopes[None, None, :, None, None] * dist, NEG)
        s = s.reshape(B, QC, H, k_sel * MB)
        m = jnp.max(s, axis=-1)
        p = jnp.exp(s - m[..., None])
        l = jnp.sum(p, axis=-1)
        acc = jnp.einsum('bqhk,bqhkd->bqhd', p, vg.reshape(B, QC, H, k_sel * MB, Dh))
        return m, l, acc

    m_sel, l_sel, acc_sel = lax.map(chunk, (qc, selc, jnp.arange(nc)))
    m_sel = m_sel.transpose(1, 0, 2, 3).reshape(B, Sp, H)
    l_sel = l_sel.transpose(1, 0, 2, 3).reshape(B, Sp, H)
    acc_sel = acc_sel.transpose(1, 0, 2, 3, 4).reshape(B, Sp, H, Dh)

    m_all = jnp.maximum(m_own, m_sel)
    w_own = jnp.exp(m_own - m_all)
    w_sel = jnp.exp(m_sel - m_all)
    out = (w_own[..., None] * acc_own + w_sel[..., None] * acc_sel) / (w_own * l_own + w_sel * l_sel)[..., None]
    return out[:, :S]


def even_mixer(h, w_in, g_qa, w_q_b, g_kva, w_kv_b, g_qn_a, g_kn_a, g_qn_b, g_kn_b, w_o):
    B, S, _ = h.shape
    proj = h @ w_in
    qkv_a = proj[..., :A_QKV].reshape(B, S, 3, A_HEADS, HEAD_DIM)
    q_lat = proj[..., A_QKV:A_QKV + Q_LORA]
    kv_lat = proj[..., A_QKV + Q_LORA:A_QKV + Q_LORA + KV_LORA]
    k_pe = proj[..., A_QKV + Q_LORA + KV_LORA:]

    qa = rmsnorm(qkv_a[:, :, 0], g_qn_a).astype(jnp.float32)
    ka = rmsnorm(qkv_a[:, :, 1], g_kn_a).astype(jnp.float32)
    va = qkv_a[:, :, 2].astype(jnp.float32)
    out_a = dilated_attention(qa, ka, va, alibi_slopes(A_HEADS))

    qb = (rmsnorm(q_lat, g_qa) @ w_q_b).reshape(B, S, B_HEADS, QK_NOPE + QK_ROPE)
    ckv = (rmsnorm(kv_lat, g_kva) @ w_kv_b).reshape(B, S, B_HEADS, QK_NOPE + V_DIM)
    k_nope, vb = ckv[..., :QK_NOPE], ckv[..., QK_NOPE:]
    kb = jnp.concatenate([k_nope, jnp.broadcast_to(k_pe[:, :, None, :], (B, S, B_HEADS, QK_ROPE))], axis=-1)
    qb = rmsnorm(qb, g_qn_b).astype(jnp.float32)
    kb = rmsnorm(kb, g_kn_b).astype(jnp.float32)
    pos = jnp.arange(S)
    qb = jnp.concatenate([qb[..., :QK_NOPE], rope(qb[..., QK_NOPE:], pos)], axis=-1)
    kb = jnp.concatenate([kb[..., :QK_NOPE], rope(kb[..., QK_NOPE:], pos)], axis=-1)
    out_b = causal_dense_attention(qb, kb, vb.astype(jnp.float32))

    mixed = jnp.concatenate([out_a.reshape(B, S, -1), out_b.reshape(B, S, -1)], axis=-1)
    return mixed.astype(h.dtype) @ w_o


def odd_mixer(h, w_qkv, g_qn, g_kn, w_o):
    B, S, _ = h.shape
    qkv = (h @ w_qkv).reshape(B, S, 3, C_HEADS, HEAD_DIM)
    q = rmsnorm(qkv[:, :, 0], g_qn).astype(jnp.float32)
    k = rmsnorm(qkv[:, :, 1], g_kn).astype(jnp.float32)
    v = qkv[:, :, 2].astype(jnp.float32)
    out = moba_attention(q, k, v, alibi_slopes(C_HEADS))
    return out.reshape(B, S, -1).astype(h.dtype) @ w_o


def grouped_moe(h, w_router, router_bias, w_gate, w_up, w_down):
    B, S, D = h.shape
    t = h.reshape(B * S, D)
    scores = jax.nn.sigmoid((t @ w_router).astype(jnp.float32))
    biased = scores + router_bias.astype(jnp.float32)
    grp = biased.reshape(-1, N_GROUPS, EXPERTS_PER_GROUP)
    grp_score = jnp.sum(lax.top_k(grp, TOP_K)[0], axis=-1)
    best = jnp.argmax(grp_score, axis=-1)
    in_group = (jnp.arange(N_EXPERTS) // EXPERTS_PER_GROUP)[None, :] == best[:, None]
    _, idx = lax.top_k(jnp.where(in_group, biased, NEG), TOP_K)
    sel = jnp.take_along_axis(scores, idx, axis=-1)
    gates = sel / jnp.sum(sel, axis=-1, keepdims=True)
    dense_gate = jnp.einsum('nk,nke->ne', gates, jax.nn.one_hot(idx, N_EXPERTS, dtype=jnp.float32))
    out = jnp.zeros((B * S, D), jnp.float32)
    for e in range(N_EXPERTS):
        y = (jax.nn.silu(t @ w_gate[e]) * (t @ w_up[e])) @ w_down[e]
        out = out + dense_gate[:, e:e + 1] * y.astype(jnp.float32)
    return out.astype(h.dtype).reshape(B, S, D)


def setup_inputs(seed: int = 0) -> dict:
    key = jax.random.key(seed)
    keys = iter(jax.random.split(key, 32))
    out_scale = (2.0 * DEPTH) ** -0.5

    def w(shape, fan_in, scale=1.0):
        return jax.random.normal(next(keys), shape, jnp.float32) * (scale * fan_in ** -0.5)

    def gain(shape):
        return 1.0 + 0.02 * jax.random.normal(next(keys), shape, jnp.float32)

    return {
        'x': jax.random.normal(next(keys), (BATCH, SEQ, D_MODEL), jnp.float32),
        'attn_norm': gain((DEPTH, D_MODEL)),
        'ev_w_in': w((N_EVEN, D_MODEL, EVEN_IN), D_MODEL),
        'ev_q_a_norm': gain((N_EVEN, Q_LORA)),
        'ev_w_q_b': w((N_EVEN, Q_LORA, B_HEADS * (QK_NOPE + QK_ROPE)), Q_LORA),
        'ev_kv_a_norm': gain((N_EVEN, KV_LORA)),
        'ev_w_kv_b': w((N_EVEN, KV_LORA, B_HEADS * (QK_NOPE + V_DIM)), KV_LORA),
        'ev_qn_a': gain((N_EVEN, HEAD_DIM)),
        'ev_kn_a': gain((N_EVEN, HEAD_DIM)),
        'ev_qn_b': gain((N_EVEN, QK_NOPE + QK_ROPE)),
        'ev_kn_b': gain((N_EVEN, QK_NOPE + QK_ROPE)),
        'ev_w_o': w((N_EVEN, EVEN_MIX, D_MODEL), EVEN_MIX, out_scale),
        'od_w_qkv': w((N_ODD, D_MODEL, 3 * ODD_MIX), D_MODEL),
        'od_qn': gain((N_ODD, HEAD_DIM)),
        'od_kn': gain((N_ODD, HEAD_DIM)),
        'od_w_o': w((N_ODD, ODD_MIX, D_MODEL), ODD_MIX, out_scale),
        'ffn_norm': gain((DEPTH, D_MODEL)),
        'w_router': w((D_MODEL, N_EXPERTS), D_MODEL),
        'router_bias': 0.01 * jax.random.normal(next(keys), (N_EXPERTS,), jnp.float32),
        'w_gate': w((DEPTH, N_EXPERTS, D_MODEL, EXPERT_FF), D_MODEL),
        'w_up': w((DEPTH, N_EXPERTS, D_MODEL, EXPERT_FF), D_MODEL),
        'w_down': w((DEPTH, N_EXPERTS, EXPERT_FF, D_MODEL), EXPERT_FF, out_scale),
    }


def reference(x, attn_norm, ev_w_in, ev_q_a_norm, ev_w_q_b, ev_kv_a_norm, ev_w_kv_b,
              ev_qn_a, ev_kn_a, ev_qn_b, ev_kn_b, ev_w_o, od_w_qkv, od_qn, od_kn, od_w_o,
              ffn_norm, w_router, router_bias, w_gate, w_up, w_down):
    h = x
    for layer in range(DEPTH):
        hn = rmsnorm(h, attn_norm[layer])
        if layer % 2 == 0:
            i = layer // 2
            h = h + even_mixer(hn, ev_w_in[i], ev_q_a_norm[i], ev_w_q_b[i], ev_kv_a_norm[i],
                               ev_w_kv_b[i], ev_qn_a[i], ev_kn_a[i], ev_qn_b[i], ev_kn_b[i], ev_w_o[i])
        else:
            i = layer // 2
            h = h + odd_mixer(hn, od_w_qkv[i], od_qn[i], od_kn[i], od_w_o[i])
        h = h + grouped_moe(rmsnorm(h, ffn_norm[layer]), w_router, router_bias,
                            w_gate[layer], w_up[layer], w_down[layer])
    return h
```

```cpp
#include <hip/hip_runtime.h>
#include <cstdio>
#include <cstdint>
#include <cmath>

#ifndef REP_PH
#define REP_PH -1
#endif
#ifndef MK_SINGLE
#define MK_SINGLE 1
#endif

#define LAS __attribute__((address_space(3)))
typedef unsigned short bf16_t;
typedef short bf16x8 __attribute__((ext_vector_type(8)));
typedef short s16x4 __attribute__((ext_vector_type(4)));
typedef float f32x4 __attribute__((ext_vector_type(4)));
typedef float f32x2 __attribute__((ext_vector_type(2)));
typedef float f32x16 __attribute__((ext_vector_type(16)));
typedef unsigned u32x4 __attribute__((ext_vector_type(4)));
typedef unsigned u32x2 __attribute__((ext_vector_type(2)));

constexpr int NTOK = 16384, DM = 2048, SEQ = 8192, NBATCH = 2;
constexpr float EPS = 1e-6f;
constexpr float LOG2E = 1.4426950408889634f;
constexpr int NPH = 19;

constexpr size_t MiB = 1024ull * 1024ull;
constexpr size_t W0_IN = 0;
constexpr size_t W0_QB = W0_IN + 4096ull * 2048 * 2;
constexpr size_t W0_KVB = W0_QB + 1536ull * 512 * 2;
constexpr size_t W0_O = W0_KVB + 2048ull * 256 * 2;
constexpr size_t W1_QKV = 0;
constexpr size_t W1_O = W1_QKV + 6144ull * 2048 * 2;
constexpr size_t W_GU = 32 * MiB;
constexpr size_t W_DN = 96 * MiB;
constexpr size_t ACT = 128 * MiB;
constexpr size_t PROJ = 192 * MiB;
constexpr size_t P_QA = PROJ, P_KA = PROJ + 32 * MiB, P_VA = PROJ + 64 * MiB;
constexpr size_t P_QLAT = PROJ + 96 * MiB, P_KVLAT = PROJ + 112 * MiB, P_KPE = PROJ + 120 * MiB;
constexpr size_t P_Q1 = PROJ, P_K1 = PROJ + 64 * MiB, P_V1 = PROJ + 128 * MiB;
constexpr size_t P_ACT2 = PROJ;
constexpr size_t P_YB = PROJ + 48 * MiB;
constexpr size_t PART = 384 * MiB;
constexpr size_t PT_PA = PART;
constexpr size_t PT_QB = PART + 64 * MiB, PT_KB = PART + 112 * MiB, PT_VB = PART + 160 * MiB;
constexpr size_t PT_H = PART;
constexpr size_t PT_PSEL = PART;
constexpr size_t SMALL = 576 * MiB;
constexpr size_t S_LA = SMALL;
constexpr size_t S_LSEL = S_LA + 1 * MiB;
constexpr size_t S_SSQQ = S_LSEL + 3 * MiB;
constexpr size_t S_SSQKV = S_SSQQ + 256 * 1024;
constexpr size_t S_ROPE = S_SSQKV + 128 * 1024;
constexpr size_t S_KPART = S_ROPE + 2 * MiB;
constexpr size_t S_MLIST = S_KPART + 4 * MiB;
constexpr size_t S_ELIST = S_MLIST + 32ull * 126976 * 4;
constexpr size_t S_TOKG = S_ELIST + 1 * MiB;
constexpr size_t S_CTL = S_TOKG + 128 * 1024;
constexpr int CTL_BAR = 0;
constexpr int CTL_ECNT = 4096;
constexpr int CTL_MCNT = CTL_ECNT + 2 * 16 * 64;
constexpr int CTL_MQ = CTL_MCNT + 1024 + 64;
constexpr int CTL_WORDS = CTL_MQ + 2 * 512;
constexpr size_t S_RSTD = S_CTL + (((size_t)CTL_WORDS * 4 + 255) & ~(size_t)255);
constexpr size_t WS_END = S_RSTD + (size_t)NTOK * 4;

constexpr int LDS_MISC = 147456;
constexpr int LDS_BYTES = LDS_MISC + 2048;

struct Params {
  const float* in[22];
  float* out;
  unsigned char* ws;
  float inv_freq[32];
  int ph_lo, ph_hi;
  int rep_ph, pad;
};
typedef const __attribute__((address_space(4))) Params* PP;

__device__ __forceinline__ int TID() { int t = threadIdx.x; asm volatile("" : "+v"(t)); return t; }
__device__ __forceinline__ unsigned cvtpk(float lo, float hi) { unsigned r; asm("v_cvt_pk_bf16_f32 %0, %1, %2" : "=v"(r) : "v"(lo), "v"(hi)); return r; }
__device__ __forceinline__ float bf2f(unsigned v) { return __uint_as_float(v << 16); }
__device__ __forceinline__ float bflo(unsigned w) { return __uint_as_float(w << 16); }
__device__ __forceinline__ float bfhi(unsigned w) { return __uint_as_float(w & 0xffff0000u); }
__device__ __forceinline__ float wave_sum(float v) {
#pragma unroll
  for (int o = 32; o >= 1; o >>= 1) v += __shfl_xor(v, o);
  return v;
}

#define XB_TMO      128
#define XB_XCNT(j)  (256  + 64 * (j))
#define XB_XSUB(j)  (1280 + 64 * (j))
#define XB_XGEN(j)  (2304 + 64 * (j))
#define XB_TOP      3328
#define XB_TOPGEN   3392
#define XCD_BAR_WORDS 3456
#define XB_SPIN_CAP (1u << 22)
__device__ __forceinline__ unsigned xb_ld(unsigned* p)              { return __hip_atomic_load(p, __ATOMIC_RELAXED, __HIP_MEMORY_SCOPE_AGENT); }
__device__ __forceinline__ unsigned xb_add(unsigned* p, unsigned v) { return __hip_atomic_fetch_add(p, v, __ATOMIC_RELAXED, __HIP_MEMORY_SCOPE_AGENT); }
__device__ __forceinline__ unsigned xb_xcc_id() { return (unsigned)__builtin_amdgcn_s_getreg((3 << 11) | 20) & 0xFu; }
#define XB_SPIN(cond, bar) do { unsigned _sp = 0; while (cond) { __builtin_amdgcn_s_sleep(1); \
    if ((++_sp & 255u) == 0u) { if (xb_ld(&(bar)[XB_TMO])) break; if (_sp > XB_SPIN_CAP) { atomicAdd(&(bar)[XB_TMO], 1u); break; } } } } while (0)
struct XcdBarrier { unsigned* bar; unsigned x; volatile LAS unsigned* st; };
__device__ __forceinline__ XcdBarrier xcd_barrier_post(unsigned* bar, volatile LAS unsigned* st) {
  XcdBarrier b; b.bar = bar; b.x = xb_xcc_id(); b.st = st;
  if (TID() == 0) (void)xb_add(&bar[XB_XCNT(b.x)], 1u);
  return b;
}
__device__ __forceinline__ void xcd_barrier_complete(unsigned* bar, unsigned x, unsigned& nloc, unsigned& nx) {
  const unsigned G = gridDim.x * gridDim.y * gridDim.z;
  unsigned sum, cnt, mine, sp = 0u;
  for (;;) {
    sum = 0u; cnt = 0u; mine = 0u;
#pragma unroll
    for (unsigned j = 0; j < 16; ++j) { const unsigned c = xb_ld(&bar[XB_XCNT(j)]); sum += c; cnt += (c > 0u) ? 1u : 0u; mine = (j == x) ? c : mine; }
    if (sum == G) break;
    __builtin_amdgcn_s_sleep(1);
    if ((++sp & 255u) == 0u) { if (xb_ld(&bar[XB_TMO])) break; if (sp > XB_SPIN_CAP) { atomicAdd(&bar[XB_TMO], 1u); break; } }
  }
  nloc = mine > 0u ? mine : 1u; nx = cnt > 0u ? cnt : 1u;
}
__device__ __forceinline__ void xcd_barrier(const XcdBarrier& b) {
  asm volatile("s_waitcnt vmcnt(0)" ::: "memory");
  __syncthreads();
  if (TID() == 0) {
    unsigned* bar = b.bar;
    __builtin_amdgcn_s_waitcnt(0);
    unsigned nloc = b.st[0], nx = b.st[1];
    if (nloc == 0u) { xcd_barrier_complete(bar, b.x, nloc, nx); b.st[0] = nloc; b.st[1] = nx; }
    const unsigned old = xb_add(&bar[XB_XSUB(b.x)], 1u);
    const unsigned gen = old / nloc;
    if (old + 1u == (gen + 1u) * nloc) {
      __builtin_amdgcn_fence(__ATOMIC_RELEASE, "agent");
      asm volatile("s_waitcnt vmcnt(0)" ::: "memory");
      const unsigned og = xb_add(&bar[XB_TOP], 1u);
      const unsigned tg = og / nx;
      if (og + 1u == (tg + 1u) * nx) xb_add(&bar[XB_TOPGEN], 1u);
      else XB_SPIN(xb_ld(&bar[XB_TOPGEN]) == tg, bar);
      __builtin_amdgcn_fence(__ATOMIC_ACQUIRE, "agent");
      xb_add(&bar[XB_XGEN(b.x)], 1u);
      asm volatile("s_waitcnt vmcnt(0)" ::: "memory");
    } else {
      XB_SPIN(xb_ld(&bar[XB_XGEN(b.x)]) == gen, bar);
      __builtin_amdgcn_fence(__ATOMIC_ACQUIRE, "agent");
      asm volatile("s_waitcnt vmcnt(0)" ::: "memory");
    }
  }
  __syncthreads();
}

struct TJob { const float* W; int K, N; bf16_t* Wt; const float* kscale; int mode; int NR; };
__device__ __forceinline__ void tjob_load(const TJob& j, int idx, int lane, f32x4 (&v)[8], float (&sc)[8]) {
  const int nkt = j.K >> 6, kt = idx % nkt, nt = idx / nkt;
  const float* src = j.W + (long)(kt * 64 + (lane >> 3)) * j.N + nt * 32 + (lane & 7) * 4;
#pragma unroll
  for (int i = 0; i < 8; ++i) v[i] = *(const f32x4*)(src + (long)(8 * i) * j.N);
#pragma unroll
  for (int i = 0; i < 8; ++i) sc[i] = j.kscale ? j.kscale[kt * 64 + (lane >> 3) + 8 * i] : 1.f;
}
__device__ __forceinline__ void tjob_store(const TJob& j, int idx, int lane, const f32x4 (&v)[8], const float (&sc)[8], LAS float* scr) {
  const int nkt = j.K >> 6, kt = idx % nkt, nt = idx / nkt;
#pragma unroll
  for (int i = 0; i < 8; ++i) { LAS float* d = scr + ((lane >> 3) + 8 * i) * 33 + (lane & 7) * 4; d[0] = v[i].x * sc[i]; d[1] = v[i].y * sc[i]; d[2] = v[i].z * sc[i]; d[3] = v[i].w * sc[i]; }
  const int kc = lane & 7;
#pragma unroll
  for (int q = 0; q < 4; ++q) {
    const int n = (lane >> 3) + 8 * q;
    const long drow = (j.mode == 0) ? (long)nt * 32 + n : (long)(nt >> 2) * 256 + ((nt & 3) >> 1) * 128 + (nt & 1) * 32 + n + (j.mode == 2 ? 64 : 0);
    const LAS float* sp = scr + (8 * kc) * 33 + n;
    u32x4 o; o.x = cvtpk(sp[0], sp[33]); o.y = cvtpk(sp[2 * 33], sp[3 * 33]); o.z = cvtpk(sp[4 * 33], sp[5 * 33]); o.w = cvtpk(sp[6 * 33], sp[7 * 33]);
    if (j.NR) *(u32x4*)(j.Wt + ((long)(2 * kt + (kc >> 2)) * j.NR + drow) * 32 + 8 * (kc & 3)) = o;
    else *(u32x4*)(j.Wt + drow * (long)j.K + kt * 64 + 8 * kc) = o;
  }
}

__device__ __forceinline__ void load_row(const float* src, int lane, f32x4 (&v)[8]) {
  const f32x4* s4 = (const f32x4*)src + lane;
#pragma unroll
  for (int i = 0; i < 8; ++i) v[i] = s4[64 * i];
}
__device__ __forceinline__ void add_bf16_row(const bf16_t* y, int lane, f32x4 (&v)[8]) {
  const u32x2* y2 = (const u32x2*)y + lane;
#pragma unroll
  for (int i = 0; i < 8; ++i) { const u32x2 w = y2[64 * i]; v[i].x += bflo(w.x); v[i].y += bfhi(w.x); v[i].z += bflo(w.y); v[i].w += bfhi(w.y); }
}
__device__ __forceinline__ void yrow_to_f32(const u32x2 (&w)[8], f32x4 (&v)[8]) {
#pragma unroll
  for (int i = 0; i < 8; ++i) { v[i].x = bflo(w[i].x); v[i].y = bfhi(w[i].x); v[i].z = bflo(w[i].y); v[i].w = bfhi(w[i].y); }
}
__device__ __forceinline__ void load_yrow(const bf16_t* y, int lane, u32x2 (&w)[8]) {
  const u32x2* y2 = (const u32x2*)y + lane;
#pragma unroll
  for (int i = 0; i < 8; ++i) w[i] = y2[64 * i];
}
__device__ __forceinline__ void add_yrow(const u32x2 (&w)[8], f32x4 (&v)[8]) {
#pragma unroll
  for (int i = 0; i < 8; ++i) { v[i].x += bflo(w[i].x); v[i].y += bfhi(w[i].x); v[i].z += bflo(w[i].y); v[i].w += bfhi(w[i].y); }
}
__device__ __forceinline__ void store_row_f32(float* dst, int lane, const f32x4 (&v)[8]) {
  f32x4* d4 = (f32x4*)dst + lane;
#pragma unroll
  for (int i = 0; i < 8; ++i) d4[64 * i] = v[i];
}
__device__ __forceinline__ float norm_row(f32x4 (&v)[8], const float* g, int lane) {
  float s = 0.f;
#pragma unroll
  for (int i = 0; i < 8; ++i) s += (v[i].x * v[i].x + v[i].y * v[i].y) + (v[i].z * v[i].z + v[i].w * v[i].w);
  s = wave_sum(s);
  const float r = rsqrtf(s * (1.f / DM) + EPS);
  const f32x4* g4 = (const f32x4*)g + lane;
#pragma unroll
  for (int i = 0; i < 8; ++i) { const f32x4 gg = g4[64 * i]; v[i] = v[i] * r * gg; }
  return r;
}
__device__ __forceinline__ void store_row_bf16(bf16_t* dst, int lane, const f32x4 (&v)[8]) {
  u32x2* d2 = (u32x2*)dst + lane;
#pragma unroll
  for (int i = 0; i < 8; ++i) { u32x2 w; w.x = cvtpk(v[i].x, v[i].y); w.y = cvtpk(v[i].z, v[i].w); d2[64 * i] = w; }
}

#define GLDS16(g, l) __builtin_amdgcn_global_load_lds((const unsigned*)(g), (LAS unsigned*)(l), 16, 0, 0)
template <int NT> struct Gemm {
  static constexpr int STG = 32768 + NT * 2048;
  static constexpr int NBI = NT / 4;
  static constexpr int NS = (3 * STG <= LDS_MISC) ? 3 : 2;
  template <class ARow, int PV = 0>
  static __device__ __forceinline__ void run(LAS unsigned char* lds, ARow arow, const char* Bt0, long ldb, int K, f32x4 (&acc)[2][NT]) {
    const int tid = TID(), lane = tid & 63, w = __builtin_amdgcn_readfirstlane(tid >> 6);
    const int fr = lane & 15, fq = lane >> 4;
    const int srow = lane >> 3, schunk = (lane & 7) ^ srow;
    const char* ap[4]; const char* bp[NBI];
#pragma unroll
    for (int i = 0; i < 4; ++i) ap[i] = arow((4 * w + i) * 8 + srow) + schunk * 16;
#pragma unroll
    for (int i = 0; i < NBI; ++i) bp[i] = Bt0 + (long)((w * NBI + i) * 8 + srow) * ldb + schunk * 16;
#pragma unroll
    for (int m = 0; m < 2; ++m)
#pragma unroll
      for (int n = 0; n < NT; ++n) acc[m][n] = (f32x4){0.f, 0.f, 0.f, 0.f};
    const int x0 = ((fq) ^ (fr & 7)) << 4, x1 = ((4 + fq) ^ (fr & 7)) << 4;
    const int abase = (32 * w + fr) * 128, bbase = 32768 + fr * 128;
    const int nk = K >> 6;
#define GEMM_STAGE(s, k0) do { \
      _Pragma("unroll") for (int i = 0; i < 4; ++i) GLDS16(ap[i] + (k0) * 2, lds + (s) * STG + (4 * w + i) * 1024); \
      _Pragma("unroll") for (int i = 0; i < NBI; ++i) GLDS16(bp[i] + (k0) * 2, lds + (s) * STG + 32768 + (w * NBI + i) * 1024); } while (0)
#define GEMM_WAIT_1() do { if (NBI == 2) asm volatile("s_waitcnt vmcnt(6)" ::: "memory"); else if (NBI == 3) asm volatile("s_waitcnt vmcnt(7)" ::: "memory"); else asm volatile("s_waitcnt vmcnt(8)" ::: "memory"); } while (0)
    GEMM_STAGE(0, 0);
    if (NS == 3 && nk > 1) GEMM_STAGE(1, 64);
    int s = 0;
    for (int kt = 0; kt < nk; ++kt) {
      if (NS == 3 && kt + 1 < nk) GEMM_WAIT_1(); else asm volatile("s_waitcnt vmcnt(0)" ::: "memory");
      __builtin_amdgcn_s_barrier();
      asm volatile("" ::: "memory");
      const bool do_stage = (kt + NS - 1 < nk) && PV != 1;
      const int sn = (s + NS - 1 >= NS) ? s - 1 : s + NS - 1; const int kn = (kt + NS - 1) * 64;
      const LAS unsigned char* sb = lds + s * STG;
      constexpr int G = NT / 4;
      bf16x8 af[2][2], bfr[2][4];
#define LDA_(kk_) do { af[kk_][0] = *(const LAS bf16x8*)(sb + abase + ((kk_) ? x1 : x0)); af[kk_][1] = *(const LAS bf16x8*)(sb + abase + 2048 + ((kk_) ? x1 : x0)); } while (0)
#define LDB_(buf_, kk_, g_) do { _Pragma("unroll") for (int j = 0; j < 4; ++j) bfr[buf_][j] = *(const LAS bf16x8*)(sb + bbase + (4 * (g_) + j) * 2048 + ((kk_) ? x1 : x0)); } while (0)
      if (PV != 2) { LDA_(0); LDB_(0, 0, 0); }
#pragma unroll
      for (int gi = 0; gi < (PV == 2 ? 0 : 2 * G); ++gi) {
        const int kk = gi / G, g = gi % G;
        if (gi + 1 < 2 * G) { const int kk2 = (gi + 1) / G, g2 = (gi + 1) % G; LDB_((gi + 1) & 1, kk2, g2); if (g2 == 0) LDA_(1); }
        if (do_stage) {
          constexpr int NGL = 4 + NBI, PER = (NGL + 2 * G - 1) / (2 * G);
#pragma unroll
          for (int q = gi * PER; q < (gi + 1) * PER && q < NGL; ++q) {
            if (q < 4) GLDS16(ap[q] + kn * 2, lds + sn * STG + (4 * w + q) * 1024);
            else GLDS16(bp[q - 4] + kn * 2, lds + sn * STG + 32768 + (w * NBI + (q - 4)) * 1024);
          }
        }
        __builtin_amdgcn_sched_barrier(0);
        __builtin_amdgcn_s_setprio(1);
#pragma unroll
        for (int j = 0; j < 4; ++j) {
          acc[0][4 * g + j] = __builtin_amdgcn_mfma_f32_16x16x32_bf16(bfr[gi & 1][j], af[kk][0], acc[0][4 * g + j], 0, 0, 0);
          acc[1][4 * g + j] = __builtin_amdgcn_mfma_f32_16x16x32_bf16(bfr[gi & 1][j], af[kk][1], acc[1][4 * g + j], 0, 0, 0);
        }
        __builtin_amdgcn_s_setprio(0);
        __builtin_amdgcn_sched_barrier(0);
      }
#undef LDA_
#undef LDB_
      s = (s + 1 == NS) ? 0 : s + 1;
    }
    asm volatile("s_waitcnt lgkmcnt(0)" ::: "memory");
    __builtin_amdgcn_s_barrier();
    asm volatile("" ::: "memory");
#undef GEMM_STAGE
#undef GEMM_WAIT_1
  }
};

struct GemmS {
  const char* ap[2]; const char* bp[2];
  long aks, bks;
  template <class ARow>
  __device__ __forceinline__ void prep(LAS unsigned char* lds, ARow arow, const char* Bt0, long bks_) {
    const int tid = TID(), lane = tid & 63, w = __builtin_amdgcn_readfirstlane(tid >> 6);
    const int prow = lane >> 2, pch = (lane & 3) ^ ((-(prow >> 2)) & 3);
    aks = 64; bks = bks_;
#pragma unroll
    for (int i = 0; i < 2; ++i) { ap[i] = arow(16 * (2 * w + i) + prow) + pch * 16; bp[i] = Bt0 + (long)(16 * (2 * w + i) + prow) * 64 + pch * 16; }
#pragma unroll
    for (int s_ = 0; s_ < 3; ++s_) issue(lds, w, s_);
  }
  __device__ __forceinline__ void issue(LAS unsigned char* lds, int w, int s_) {
    const int sl_ = (s_ & 3) * 32768; const long ka_ = (long)s_ * aks, kb_ = (long)s_ * bks;
    GLDS16(ap[0] + ka_, lds + sl_ + (2 * w) * 1024); GLDS16(ap[1] + ka_, lds + sl_ + (2 * w + 1) * 1024);
    GLDS16(bp[0] + kb_, lds + sl_ + 16384 + (2 * w) * 1024); GLDS16(bp[1] + kb_, lds + sl_ + 16384 + (2 * w + 1) * 1024);
  }
  __device__ __forceinline__ void main(LAS unsigned char* lds, int K, f32x4 (&acc)[4][8]) {
    const int tid = TID(), lane = tid & 63, w = __builtin_amdgcn_readfirstlane(tid >> 6), half = w >> 2, wm = w & 3;
    const int fr = lane & 15, fq = lane >> 4;
#pragma unroll
    for (int m = 0; m < 4; ++m)
#pragma unroll
      for (int n = 0; n < 8; ++n) acc[m][n] = (f32x4){0.f, 0.f, 0.f, 0.f};
    const int rbase = fr * 64 + ((fq ^ ((-(fr >> 2)) & 3)) << 4);
    const int S = K >> 5;
#define GS_BAR() do { __builtin_amdgcn_s_barrier(); asm volatile("" ::: "memory"); } while (0)
    asm volatile("s_waitcnt vmcnt(4)" ::: "memory");
    GS_BAR();
    if (half == 1) GS_BAR();
#pragma unroll 1
    for (int s = 0; s < S; ++s) {
      const LAS unsigned char* sb = lds + (s & 3) * 32768 + rbase;
      bf16x8 af[4], bfr[8];
#pragma unroll
      for (int m = 0; m < 4; ++m) af[m] = *(const LAS bf16x8*)(sb + (64 * wm + 16 * m) * 64);
#pragma unroll
      for (int n = 0; n < 8; ++n) bfr[n] = *(const LAS bf16x8*)(sb + 16384 + (128 * half + 16 * n) * 64);
      if (s + 3 < S) issue(lds, w, s + 3);
      const int c = (s + 3 < S ? 1 : 0) + (s + 2 < S ? 1 : 0);
      if (c == 2) asm volatile("s_waitcnt vmcnt(8)" ::: "memory"); else if (c == 1) asm volatile("s_waitcnt vmcnt(4)" ::: "memory"); else asm volatile("s_waitcnt vmcnt(0)" ::: "memory");
      asm volatile("s_waitcnt lgkmcnt(0)" ::: "memory");
      GS_BAR();
      __builtin_amdgcn_sched_barrier(0);
      __builtin_amdgcn_s_setprio(1);
#pragma unroll
      for (int n = 0; n < 8; ++n)
#pragma unroll
        for (int m = 0; m < 4; ++m) acc[m][n] = __builtin_amdgcn_mfma_f32_16x16x32_bf16(bfr[n], af[m], acc[m][n], 0, 0, 0);
      __builtin_amdgcn_s_setprio(0);
      __builtin_amdgcn_sched_barrier(0);
      GS_BAR();
    }
    if (half == 0) GS_BAR();
#undef GS_BAR
  }
};
template <class PrepFn, class EpiFn>
__device__ __forceinline__ void gemms_phase(LAS unsigned char* lds, int ntiles, int K, PrepFn prep_tile, EpiFn epi) {
  GemmS g;
  int t = blockIdx.x;
  if (t < ntiles) prep_tile(t, g);
  while (t < ntiles) {
    const int tn = t + gridDim.x;
    f32x4 acc[4][8];
    g.main(lds, K, acc);
    if (tn < ntiles) prep_tile(tn, g);
    epi(t, acc);
    t = tn;
  }
}
__device__ __forceinline__ void tile_map(int t, int nRT, int nNT, int& rt, int& nt) {
  const int per = 16 * nNT, g = t / per, r = t - g * per, rem = nRT - 16 * g, gsz = rem < 16 ? rem : 16;
  rt = 16 * g + r % gsz; nt = r / gsz;
}
template <int NT> __device__ __forceinline__ float rowssq(const f32x4 (&a)[NT]) {
  float s = 0.f;
#pragma unroll
  for (int n = 0; n < NT; ++n) s += (a[n].x * a[n].x + a[n].y * a[n].y) + (a[n].z * a[n].z + a[n].w * a[n].w);
  s += __shfl_xor(s, 16); s += __shfl_xor(s, 32);
  return s;
}
__device__ __forceinline__ void store4(bf16_t* p, f32x4 v) { u32x2 w; w.x = cvtpk(v.x, v.y); w.y = cvtpk(v.z, v.w); *(u32x2*)p = w; }

__device__ __forceinline__ void phase_inproj(PP p, LAS unsigned char* lds) {
  unsigned char* ws = p->ws;
  const bf16_t* A = (const bf16_t*)(ws + ACT); const char* Bt = (const char*)(ws + W0_IN);
  const int lane = TID() & 63, w = __builtin_amdgcn_readfirstlane(TID() >> 6); int fr = lane & 15, fq = lane >> 4;
  gemms_phase(lds, 64 * 16, 2048,
    [&](int t, GemmS& g) { int rt, nt2; tile_map(t, 64, 16, rt, nt2); g.prep(lds, [&](int r) { return (const char*)(A + (long)(rt * 256 + r) * 2048); }, Bt + (long)nt2 * 256 * 64, 4096l * 64); },
    [&](int t, f32x4 (&acc)[4][8]) {
    int rt, nt2; tile_map(t, 64, 16, rt, nt2);
    asm volatile("" : "+v"(fr), "+v"(fq));
    {
      const int nt = nt2 * 2 + (w >> 2);
#pragma unroll
      for (int m = 0; m < 4; ++m) {
        f32x4 a[8];
#pragma unroll
        for (int n = 0; n < 8; ++n) a[n] = acc[m][n];
        const long tok = rt * 256 + 64 * (w & 3) + 16 * m + fr;
        if (nt < 24) {
          const int which = nt >> 3, h = nt & 7;
          bf16_t* dst = (bf16_t*)(ws + (which == 0 ? P_QA : which == 1 ? P_KA : P_VA)) + tok * 1024 + h * 128 + 4 * fq;
          if (which < 2) {
            const float r = rsqrtf(rowssq<8>(a) * (1.f / 128.f) + EPS);
            const float* g = p->in[which == 0 ? 7 : 8] + 4 * fq;
#pragma unroll
            for (int n = 0; n < 8; ++n) store4(dst + 16 * n, a[n] * r * *(const f32x4*)(g + 16 * n));
          } else {
#pragma unroll
            for (int n = 0; n < 8; ++n) store4(dst + 16 * n, a[n]);
          }
        } else if (nt < 28) {
          const int c = nt - 24;
          bf16_t* dst = (bf16_t*)(ws + P_QLAT) + tok * 512 + c * 128 + 4 * fq;
          const float sq = rowssq<8>(a);
          if (fq == 0) ((float*)(ws + S_SSQQ))[tok * 4 + c] = sq;
#pragma unroll
          for (int n = 0; n < 8; ++n) store4(dst + 16 * n, a[n]);
        } else if (nt < 30) {
          const int c = nt - 28;
          bf16_t* dst = (bf16_t*)(ws + P_KVLAT) + tok * 256 + c * 128 + 4 * fq;
          const float sq = rowssq<8>(a);
          if (fq == 0) ((float*)(ws + S_SSQKV))[tok * 2 + c] = sq;
#pragma unroll
          for (int n = 0; n < 8; ++n) store4(dst + 16 * n, a[n]);
        } else if (nt == 30) {
          bf16_t* dst = (bf16_t*)(ws + P_KPE) + tok * 64 + 4 * fq;
#pragma unroll
          for (int n = 0; n < 4; ++n) store4(dst + 16 * n, a[n]);
        }
      }
    }
  });
}

__device__ __forceinline__ void phase_qkvb(PP p, LAS unsigned char* lds) {
  unsigned char* ws = p->ws;
  const int lane = TID() & 63, w = __builtin_amdgcn_readfirstlane(TID() >> 6); int fr = lane & 15, fq = lane >> 4;
  const float* rope = (const float*)(ws + S_ROPE);
  {
    const bf16_t* A = (const bf16_t*)(ws + P_QLAT); const char* Bt = (const char*)(ws + W0_QB);
    const float* ssq = (const float*)(ws + S_SSQQ); const float* g = p->in[9] + 4 * fq;
    bf16_t* QB = (bf16_t*)(ws + PT_QB);
    for (int t = blockIdx.x; t < 64 * 8; t += gridDim.x) {
      int rt, h; tile_map(t, 64, 8, rt, h);
      f32x4 acc[2][12];
      Gemm<12>::run(lds, [&](int r) { return (const char*)(A + (long)(rt * 256 + r) * 512); }, Bt + (long)h * 192 * 1024, 1024, 512, acc);
    asm volatile("" : "+v"(fr), "+v"(fq));
#pragma unroll
      for (int m = 0; m < 2; ++m) {
        const long tok = rt * 256 + 32 * w + 16 * m + fr;
        const f32x4 sq = *(const f32x4*)(ssq + tok * 4);
        const float rstd = rsqrtf(((sq.x + sq.y) + (sq.z + sq.w)) * (1.f / 512.f) + EPS);
#pragma unroll
        for (int n = 0; n < 12; ++n) acc[m][n] = acc[m][n] * rstd;
        const float r2 = rsqrtf(rowssq<12>(acc[m]) * (1.f / 192.f) + EPS);
#pragma unroll
        for (int n = 0; n < 12; ++n) acc[m][n] = acc[m][n] * r2 * *(const f32x4*)(g + 16 * n);
        const int pos = (int)(tok & (SEQ - 1));
#pragma unroll
        for (int a = 0; a < 2; ++a) {
          const f32x4 cs0 = *(const f32x4*)(rope + ((long)pos * 32 + 16 * a + 4 * fq) * 2), cs1 = *(const f32x4*)(rope + ((long)pos * 32 + 16 * a + 4 * fq) * 2 + 4);
          const f32x4 c = {cs0.x, cs0.z, cs1.x, cs1.z}, s = {cs0.y, cs0.w, cs1.y, cs1.w};
          const f32x4 x1 = acc[m][8 + a], x2 = acc[m][10 + a];
          acc[m][8 + a] = x1 * c - x2 * s; acc[m][10 + a] = x1 * s + x2 * c;
        }
        bf16_t* dst = QB + tok * 1536 + h * 192 + 4 * fq;
#pragma unroll
        for (int n = 0; n < 12; ++n) store4(dst + 16 * n, acc[m][n]);
      }
    }
  }
  {
    const bf16_t* A = (const bf16_t*)(ws + P_KVLAT); const char* Bt = (const char*)(ws + W0_KVB);
    const float* ssq = (const float*)(ws + S_SSQKV); const float* g = p->in[10];
    const bf16_t* KPE = (const bf16_t*)(ws + P_KPE);
    bf16_t* KB = (bf16_t*)(ws + PT_KB); bf16_t* VB = (bf16_t*)(ws + PT_VB);
    gemms_phase(lds, 64 * 8, 256,
      [&](int t, GemmS& g) { int rt, h; tile_map(t, 64, 8, rt, h); g.prep(lds, [&](int r) { return (const char*)(A + (long)(rt * 256 + r) * 256); }, Bt + (long)h * 256 * 64, 2048l * 64); },
      [&](int t, f32x4 (&acc)[4][8]) {
      int rt, h; tile_map(t, 64, 8, rt, h);
    asm volatile("" : "+v"(fr), "+v"(fq));
#pragma unroll
      for (int m = 0; m < 4; ++m) {
        const long tok = rt * 256 + 64 * (w & 3) + 16 * m + fr;
        const float rstd = rsqrtf((ssq[tok * 2] + ssq[tok * 2 + 1]) * (1.f / 256.f) + EPS);
        f32x4 kn[8];
#pragma unroll
        for (int n = 0; n < 8; ++n) kn[n] = acc[m][n] * rstd;
        if (w >> 2) {
          bf16_t* dst = VB + tok * 1024 + h * 128 + 4 * fq;
#pragma unroll
          for (int n = 0; n < 8; ++n) store4(dst + 16 * n, kn[n]);
        } else {
          const u32x4 pa = *(const u32x4*)(KPE + tok * 64 + 8 * fq), pb = *(const u32x4*)(KPE + tok * 64 + 32 + 8 * fq);
          float e1[8] = {bflo(pa.x), bfhi(pa.x), bflo(pa.y), bfhi(pa.y), bflo(pa.z), bfhi(pa.z), bflo(pa.w), bfhi(pa.w)};
          float e2[8] = {bflo(pb.x), bfhi(pb.x), bflo(pb.y), bfhi(pb.y), bflo(pb.z), bfhi(pb.z), bflo(pb.w), bfhi(pb.w)};
          float spe = 0.f;
#pragma unroll
          for (int e = 0; e < 8; ++e) spe += e1[e] * e1[e] + e2[e] * e2[e];
          spe += __shfl_xor(spe, 16); spe += __shfl_xor(spe, 32);
          const float rk = rsqrtf((rowssq<8>(kn) + spe) * (1.f / 192.f) + EPS);
          bf16_t* dst = KB + tok * 1536 + h * 192;
#pragma unroll
          for (int n = 0; n < 8; ++n) store4(dst + 16 * n + 4 * fq, kn[n] * rk * *(const f32x4*)(g + 16 * n + 4 * fq));
          const int pos = (int)(tok & (SEQ - 1));
          const float* cs = rope + ((long)pos * 32 + 8 * fq) * 2;
          float o1[8], o2[8];
#pragma unroll
          for (int e = 0; e < 8; ++e) {
            const float x = e1[e] * rk * g[128 + 8 * fq + e], y = e2[e] * rk * g[160 + 8 * fq + e], c = cs[2 * e], sn = cs[2 * e + 1];
            o1[e] = x * c - y * sn; o2[e] = x * sn + y * c;
          }
          u32x4 w1 = {cvtpk(o1[0], o1[1]), cvtpk(o1[2], o1[3]), cvtpk(o1[4], o1[5]), cvtpk(o1[6], o1[7])};
          u32x4 w2 = {cvtpk(o2[0], o2[1]), cvtpk(o2[2], o2[3]), cvtpk(o2[4], o2[5]), cvtpk(o2[6], o2[7])};
          *(u32x4*)(dst + 128 + 8 * fq) = w1; *(u32x4*)(dst + 160 + 8 * fq) = w2;
        }
      }
    });
  }
}

__device__ __forceinline__ void phase_outproj(PP p, LAS unsigned char* lds, const char* Bt, const float* __restrict__ resid, bf16_t* __restrict__ dst) {
  unsigned char* ws = p->ws;
  const bf16_t* A = (const bf16_t*)(ws + ACT);
  const int lane = TID() & 63, w = __builtin_amdgcn_readfirstlane(TID() >> 6); int fr = lane & 15, fq = lane >> 4;
  gemms_phase(lds, 64 * 8, 2048,
    [&](int t, GemmS& g) { int rt, nt; tile_map(t, 64, 8, rt, nt); g.prep(lds, [&](int r) { return (const char*)(A + (long)(rt * 256 + r) * 2048); }, Bt + (long)nt * 256 * 64, 2048l * 64); },
    [&](int t, f32x4 (&acc)[4][8]) {
    int rt, nt; tile_map(t, 64, 8, rt, nt);
    asm volatile("" : "+v"(fr), "+v"(fq));
#pragma unroll
    for (int m = 0; m < 4; ++m) {
      const long off = (long)(rt * 256 + 64 * (w & 3) + 16 * m + fr) * 2048 + nt * 256 + 128 * (w >> 2) + 4 * fq;
      f32x4 rv[8];
#pragma unroll
      for (int n = 0; n < 8; ++n) rv[n] = *(const f32x4*)(resid + off + 16 * n);
#pragma unroll
      for (int n = 0; n < 8; ++n) store4(dst + off + 16 * n, rv[n] + acc[m][n]);
    }
  });
}

__device__ __forceinline__ void phase_qkv1(PP p, LAS unsigned char* lds) {
  unsigned char* ws = p->ws;
  const bf16_t* A = (const bf16_t*)(ws + ACT); const char* Bt = (const char*)(ws + W1_QKV);
  const int lane = TID() & 63, w = __builtin_amdgcn_readfirstlane(TID() >> 6); int fr = lane & 15, fq = lane >> 4;
  float* kpart = (float*)(ws + S_KPART);
  gemms_phase(lds, 64 * 24, 2048,
    [&](int t, GemmS& g) { int rt, nt2; tile_map(t, 64, 24, rt, nt2); g.prep(lds, [&](int r) { return (const char*)(A + (long)(rt * 256 + r) * 2048); }, Bt + (long)nt2 * 256 * 64, 6144l * 64); },
    [&](int t, f32x4 (&acc)[4][8]) {
    int rt, nt2; tile_map(t, 64, 24, rt, nt2);
    asm volatile("" : "+v"(fr), "+v"(fq));
    const int which = nt2 >> 3;
    bf16_t* base = (bf16_t*)(ws + (which == 0 ? P_Q1 : which == 1 ? P_K1 : P_V1));
    const int h = (nt2 * 2 + (w >> 2)) & 15, wm = w & 3;
    if (which < 2) {
      const float* g = p->in[which == 0 ? 13 : 14] + 4 * fq;
#pragma unroll
      for (int m = 0; m < 4; ++m) {
        const float r = rsqrtf(rowssq<8>(acc[m]) * (1.f / 128.f) + EPS);
#pragma unroll
        for (int n = 0; n < 8; ++n) acc[m][n] = acc[m][n] * r * *(const f32x4*)(g + 16 * n);
      }
      if (which == 1) {
#pragma unroll
        for (int c2 = 0; c2 < 2; ++c2) {
          float* kp = kpart + ((long)(rt * 8 + wm * 2 + c2) * 16 + h) * 128 + 4 * fq;
#pragma unroll
          for (int n = 0; n < 8; ++n) {
            f32x4 sm = acc[2 * c2][n] + acc[2 * c2 + 1][n];
#pragma unroll
            for (int o = 1; o < 16; o <<= 1) { sm.x += __shfl_xor(sm.x, o); sm.y += __shfl_xor(sm.y, o); sm.z += __shfl_xor(sm.z, o); sm.w += __shfl_xor(sm.w, o); }
            if (fr == 0) *(f32x4*)(kp + 16 * n) = sm;
          }
        }
      }
    }
#pragma unroll
    for (int m = 0; m < 4; ++m) {
      bf16_t* dst = base + (long)(rt * 256 + 64 * wm + 16 * m + fr) * 2048 + h * 128 + 4 * fq;
#pragma unroll
      for (int n = 0; n < 8; ++n) store4(dst + 16 * n, acc[m][n]);
    }
  });
}

__device__ __forceinline__ TJob moe_tjob(PP p, int layer, int idx, int& sub) {
  unsigned char* ws = p->ws;
  const int kind = idx >> 13, r = idx & 8191, e = r >> 9; sub = r & 511;
  TJob j;
  if (kind < 2) { j.W = p->in[kind == 0 ? 19 : 20] + ((long)layer * 16 + e) * 2048 * 512; j.K = 2048; j.N = 512; j.Wt = (bf16_t*)(ws + W_GU) + (long)e * 1024 * 2048; j.kscale = p->in[16] + layer * 2048; j.mode = 1 + kind; j.NR = 1024; }
  else { j.W = p->in[21] + ((long)layer * 16 + e) * 512 * 2048; j.K = 512; j.N = 2048; j.Wt = (bf16_t*)(ws + W_DN) + (long)e * 2048 * 512; j.kscale = nullptr; j.mode = 0; j.NR = 2048; }
  return j;
}
__device__ __forceinline__ TJob tjob0(PP p, int it, int& sub) {
  unsigned char* ws = p->ws;
  constexpr int J_IN = 32 * 122, J_QB = 8 * 48, J_KVB = 4 * 64, J_O = 32 * 64;
  int r = it;
  if (r < J_IN) { sub = r; return TJob{p->in[2], 2048, 3904, (bf16_t*)(ws + W0_IN), nullptr, 0, 4096}; } r -= J_IN;
  if (r < J_QB) { sub = r; return TJob{p->in[4], 512, 1536, (bf16_t*)(ws + W0_QB), p->in[3], 0, 0}; } r -= J_QB;
  if (r < J_KVB) { sub = r; return TJob{p->in[6], 256, 2048, (bf16_t*)(ws + W0_KVB), p->in[5], 0, 2048}; } r -= J_KVB;
  if (r < J_O) { sub = r; return TJob{p->in[11], 2048, 2048, (bf16_t*)(ws + W0_O), nullptr, 0, 2048}; } r -= J_O;
  return moe_tjob(p, 0, r, sub);
}
__device__ __forceinline__ TJob tjob1(PP p, int it, int& sub) {
  unsigned char* ws = p->ws;
  constexpr int J_QKV = 32 * 192, J_O = 32 * 64;
  int r = it;
  if (r < J_QKV) { sub = r; return TJob{p->in[12], 2048, 6144, (bf16_t*)(ws + W1_QKV), nullptr, 0, 6144}; } r -= J_QKV;
  if (r < J_O) { sub = r; return TJob{p->in[15], 2048, 2048, (bf16_t*)(ws + W1_O), nullptr, 0, 2048}; } r -= J_O;
  return moe_tjob(p, 1, r, sub);
}
template <int LAYER> __device__ __forceinline__ void run_tjobs_core(PP p, LAS unsigned char* lds, int it0, int stride, int jhi) {
  const int lane = TID() & 63, wave = TID() >> 6;
  LAS float* scr = (LAS float*)lds + wave * (64 * 33);
  int it = it0 + wave;
  f32x4 va[8], vb[8], vc[8]; float sa[8], sb[8], sc[8];
  if (it < jhi) { int sub; const TJob j = LAYER == 0 ? tjob0(p, it, sub) : tjob1(p, it, sub); tjob_load(j, sub, lane, va, sa); }
  if (it + stride < jhi) { int sub; const TJob j = LAYER == 0 ? tjob0(p, it + stride, sub) : tjob1(p, it + stride, sub); tjob_load(j, sub, lane, vb, sb); }
  while (it < jhi) {
    const int nx = it + stride, nx2 = nx + stride;
    if (nx2 < jhi) { int sub; const TJob j = LAYER == 0 ? tjob0(p, nx2, sub) : tjob1(p, nx2, sub); tjob_load(j, sub, lane, vc, sc); }
    { int sub; const TJob j = LAYER == 0 ? tjob0(p, it, sub) : tjob1(p, it, sub); tjob_store(j, sub, lane, va, sa, scr); }
#pragma unroll
    for (int i = 0; i < 8; ++i) { va[i] = vb[i]; vb[i] = vc[i]; sa[i] = sb[i]; sb[i] = sc[i]; }
    it = nx;
  }
}
template <int LAYER> __device__ __forceinline__ void run_tjobs(PP p, LAS unsigned char* lds, int jlo, int jhi, int first) {
  if ((int)blockIdx.x < first) return;
  run_tjobs_core<LAYER>(p, lds, jlo + (blockIdx.x - first) * 8, (gridDim.x - first) * 8, jhi);
}
template <int LAYER> __device__ __forceinline__ void run_tjobs_blk(PP p, LAS unsigned char* lds, int jlo, int jhi) {
  run_tjobs_core<LAYER>(p, lds, jlo, 8, jhi);
}
constexpr int TJ0_DENSE = 32 * 122 + 8 * 48 + 4 * 64 + 32 * 64, TJ0_TOTAL = TJ0_DENSE + 24576;
constexpr int TJ1_DENSE = 32 * 192 + 32 * 64, TJ1_GU = 16384, TJ1_TOTAL = TJ1_DENSE + 24576;
__device__ __forceinline__ void moe_setup(PP p, int layer, LAS int* mi) {
  if (TID() == 0) {
    const unsigned* cnt = (const unsigned*)(p->ws + S_CTL) + CTL_ECNT + layer * 16 * 64;
    int acc = 0;
    for (int e = 0; e < 16; ++e) { const int c = (int)cnt[e * 64]; mi[e] = acc; mi[17 + e] = c; acc += (c + 255) >> 8; }
    mi[16] = acc;
  }
  __syncthreads();
}
__device__ __forceinline__ int moe_expert_of(const LAS int* mi, int R) {
  int e = 0;
#pragma unroll
  for (int k = 1; k < 16; ++k) if (R >= mi[k]) e = k;
  return e;
}
constexpr int TJ_CHUNK = 64;
__device__ __forceinline__ void phase_moe(PP p, LAS unsigned char* lds, int layer) {
  unsigned char* ws = p->ws;
  LAS int* mi = (LAS int*)(lds + LDS_MISC + 64);
  moe_setup(p, layer, mi);
  const int totRT = mi[16], n7 = totRT * 4, n8 = totRT * 8;
  const bf16_t* A = (const bf16_t*)(ws + PT_H);
  const float* rstd = (const float*)(ws + S_RSTD);
  const unsigned* elist = (const unsigned*)(ws + S_ELIST);
  bf16_t* act2 = (bf16_t*)(ws + P_ACT2);
  const float* tokg = (const float*)(ws + S_TOKG);
  bf16_t* yb = (bf16_t*)(ws + P_YB);
  unsigned* mq = (unsigned*)(ws + S_CTL) + CTL_MQ + layer * 512;
  unsigned* barw = (unsigned*)(ws + S_CTL) + CTL_BAR;
  const int lane = TID() & 63, w = __builtin_amdgcn_readfirstlane(TID() >> 6); int fr = lane & 15, fq = lane >> 4;
  gemms_phase(lds, n7, 2048,
    [&](int t, GemmS& g) { int R, j4; tile_map(t, totRT, 4, R, j4);
      const int e = moe_expert_of(mi, R), cnt = mi[17 + e], lrow0 = (R - mi[e]) * 256; const unsigned* el = elist + e * 16384;
      g.prep(lds, [&](int r) { int li = lrow0 + r; li = li < cnt ? li : cnt - 1; const unsigned tok = el[li] >> 1; return (const char*)(A + (long)tok * 2048); },
             (const char*)(ws + W_GU) + (long)e * 1024 * 4096 + (long)j4 * 256 * 64, 1024l * 64); },
    [&](int t, f32x4 (&acc)[4][8]) {
    int R, j4; tile_map(t, totRT, 4, R, j4);
    const int e = moe_expert_of(mi, R), cnt = mi[17 + e], lrow0 = (R - mi[e]) * 256;
    asm volatile("" : "+v"(fr), "+v"(fq));
#pragma unroll
    for (int m = 0; m < 4; ++m) {
      const int lr = 64 * (w & 3) + 16 * m + fr;
      if (lrow0 + lr < cnt) {
        bf16_t* dst = act2 + ((long)R * 256 + lr) * 512 + j4 * 128 + 64 * (w >> 2) + 4 * fq;
        const float rs = rstd[elist[e * 16384 + lrow0 + lr] >> 1];
#pragma unroll
        for (int n = 0; n < 4; ++n) {
          const f32x4 g = acc[m][n] * rs, u = acc[m][n + 4] * rs; f32x4 a;
          a.x = g.x * __builtin_amdgcn_rcpf(1.f + __builtin_amdgcn_exp2f(-g.x * LOG2E)) * u.x;
          a.y = g.y * __builtin_amdgcn_rcpf(1.f + __builtin_amdgcn_exp2f(-g.y * LOG2E)) * u.y;
          a.z = g.z * __builtin_amdgcn_rcpf(1.f + __builtin_amdgcn_exp2f(-g.z * LOG2E)) * u.z;
          a.w = g.w * __builtin_amdgcn_rcpf(1.f + __builtin_amdgcn_exp2f(-g.w * LOG2E)) * u.w;
          store4(dst + 16 * n, a);
        }
      }
    }
    asm volatile("s_waitcnt vmcnt(0)" ::: "memory");
    __syncthreads();
    if (TID() == 0) {
      __builtin_amdgcn_fence(__ATOMIC_RELEASE, "agent");
      asm volatile("s_waitcnt vmcnt(0)" ::: "memory");
      (void)xb_add(&mq[128 + R], 1u); (void)xb_add(&mq[64], 1u);
    }
  });
  const int ncv1 = layer == 0 ? TJ1_DENSE / TJ_CHUNK : 0, ncv = layer == 0 ? (TJ1_DENSE + TJ1_GU) / TJ_CHUNK : 0, nitems = n8 + ncv;
  volatile LAS int* qs = (volatile LAS int*)(lds + LDS_MISC + 32);
  int all7 = 0, upto = 0;
  auto post = [&](unsigned nx_, unsigned d7v_, int slot) {
    const int nx = (int)__builtin_amdgcn_readfirstlane(nx_), d7v = (int)__builtin_amdgcn_readfirstlane(d7v_);
    if (!all7) {
      if (nx < n8) {
        int R, nt; tile_map(nx, totRT, 8, R, nt);
        if (R >= upto) {
          if (d7v == n7) all7 = 1;
          else {
            XB_SPIN(xb_ld(&mq[128 + R]) < 4u, barw);
            const int rr = upto + lane;
            const unsigned c = rr < totRT ? xb_ld(&mq[128 + rr]) : 0u;
            const unsigned long long okm = __builtin_amdgcn_ballot_w64(c >= 4u);
            const int pre = okm == ~0ull ? 64 : __builtin_ctzll(~okm);
            upto = upto + pre;
          }
          __builtin_amdgcn_fence(__ATOMIC_ACQUIRE, "agent");
        }
      } else if (nx >= n8 + ncv1 && nx < nitems) {
        XB_SPIN(xb_ld(&mq[64]) != (unsigned)n7, barw);
        all7 = 1;
        __builtin_amdgcn_fence(__ATOMIC_ACQUIRE, "agent");
      }
    }
    if (lane == 0) qs[slot] = nx;
  };
  auto prep8 = [&](int q, GemmS& g) { int R, nt; tile_map(q, totRT, 8, R, nt); const int e = moe_expert_of(mi, R);
    g.prep(lds, [&](int r) { return (const char*)(act2 + ((long)R * 256 + r) * 512); }, (const char*)(ws + W_DN) + (long)e * 2048 * 1024 + (long)nt * 256 * 64, 2048l * 64); };
  int par = 0;
  if (w == 0) { unsigned nx = 0u, dv = 0u; if (lane == 0) { nx = xb_add(&mq[0], 1u); dv = xb_ld(&mq[64]); } post(nx, dv, par); }
  __syncthreads();
  int q = qs[par];
  GemmS g;
  if (q < n8) prep8(q, g);
  while (q < n8) {
    unsigned nx = 0u, dv = 0u;
    if (TID() == 0) { nx = xb_add(&mq[0], 1u); if (!all7) dv = xb_ld(&mq[64]); }
    f32x4 acc[4][8];
    g.main(lds, 512, acc);
    par ^= 1;
    if (w == 0) post(nx, dv, par);
    __syncthreads();
    const int qn = qs[par];
    if (qn < n8) prep8(qn, g);
    {
      int R, nt; tile_map(q, totRT, 8, R, nt);
      const int e = moe_expert_of(mi, R), cnt = mi[17 + e], lrow0 = (R - mi[e]) * 256;
      asm volatile("" : "+v"(fr), "+v"(fq));
#pragma unroll
      for (int m = 0; m < 4; ++m) {
        const int lr = lrow0 + 64 * (w & 3) + 16 * m + fr;
        if (lr < cnt) {
          const unsigned ent = elist[e * 16384 + lr]; const unsigned tok = ent >> 1, slot = ent & 1u;
          const float gate = tokg[tok * 2 + slot];
          bf16_t* dst = yb + ((long)slot * NTOK + tok) * 2048 + nt * 256 + 128 * (w >> 2) + 4 * fq;
#pragma unroll
          for (int n = 0; n < 8; ++n) store4(dst + 16 * n, acc[m][n] * gate);
        }
      }
    }
    q = qn;
  }
  while (q < nitems) {
    unsigned nx = 0u;
    if (TID() == 0) nx = xb_add(&mq[0], 1u);
    const int j0 = (q - n8) * TJ_CHUNK;
    run_tjobs_blk<1>(p, lds, j0, j0 + TJ_CHUNK);
    par ^= 1;
    if (w == 0) post(nx, 0u, par);
    __syncthreads();
    q = qs[par];
  }
}

__device__ __forceinline__ void phase_router(PP p, LAS unsigned char* lds, int layer) {
  unsigned char* ws = p->ws;
  LAS float* wr = (LAS float*)lds;
  const int tid = TID(), lane = tid & 63, wave = tid >> 6;
  {
    const f32x4* wsrc = (const f32x4*)p->in[17];
    f32x4 tmp[16];
#pragma unroll
    for (int i = 0; i < 16; ++i) tmp[i] = wsrc[tid + 512 * i];
#pragma unroll
    for (int i = 0; i < 16; ++i) { const int idx = tid + 512 * i, d = idx >> 2, c4 = idx & 3;
      wr[(4 * c4 + 0) * 2048 + d] = tmp[i].x; wr[(4 * c4 + 1) * 2048 + d] = tmp[i].y; wr[(4 * c4 + 2) * 2048 + d] = tmp[i].z; wr[(4 * c4 + 3) * 2048 + d] = tmp[i].w; }
  }
  __syncthreads();
  LAS int* selE = (LAS int*)(lds + LDS_MISC + 256);
  LAS float* selG = (LAS float*)(lds + LDS_MISC + 768);
  const float* gvec = p->in[16] + layer * 2048;
  const float* rb = p->in[18];
  const bf16_t* hsrc = (const bf16_t*)(ws + PT_H);
  unsigned* cnt = (unsigned*)(ws + S_CTL) + CTL_ECNT + layer * 16 * 64;
  unsigned* elist = (unsigned*)(ws + S_ELIST);
  float* tokg = (float*)(ws + S_TOKG);
  const bool hb5 = (lane & 32) != 0, hb4 = (lane & 16) != 0, hb3 = (lane & 8) != 0, hb2 = (lane & 4) != 0;
  float* rstd = (float*)(ws + S_RSTD);
  auto finish = [&](float (&sacc)[16], int lrow) __attribute__((always_inline)) {
      float t8[8], t4[4], t2[2], t1;
#pragma unroll
      for (int k = 0; k < 8; ++k) { const float snd = hb5 ? sacc[k] : sacc[k + 8], kp = hb5 ? sacc[k + 8] : sacc[k]; t8[k] = kp + __shfl_xor(snd, 32); }
#pragma unroll
      for (int k = 0; k < 4; ++k) { const float snd = hb4 ? t8[k] : t8[k + 4], kp = hb4 ? t8[k + 4] : t8[k]; t4[k] = kp + __shfl_xor(snd, 16); }
#pragma unroll
      for (int k = 0; k < 2; ++k) { const float snd = hb3 ? t4[k] : t4[k + 2], kp = hb3 ? t4[k + 2] : t4[k]; t2[k] = kp + __shfl_xor(snd, 8); }
      { const float snd = hb2 ? t2[0] : t2[1], kp = hb2 ? t2[1] : t2[0]; t1 = kp + __shfl_xor(snd, 4); }
      t1 += __shfl_xor(t1, 2); t1 += __shfl_xor(t1, 1);
      float lg[16];
#pragma unroll
      for (int e = 0; e < 16; ++e) lg[e] = __uint_as_float(__builtin_amdgcn_readlane(__float_as_uint(t1), 32 * (e >> 3) + 16 * ((e >> 2) & 1) + 8 * ((e >> 1) & 1) + 4 * (e & 1)));
      float sc[16], bs[16];
#pragma unroll
      for (int e = 0; e < 16; ++e) { sc[e] = 1.f / (1.f + __expf(-lg[e])); bs[e] = sc[e] + rb[e]; }
      float bestGS = -3.0e38f, S1 = 0.f, S2 = 0.f; int E1 = 0, E2 = 1;
#pragma unroll
      for (int g = 0; g < 4; ++g) {
        const float b0 = bs[4 * g], b1 = bs[4 * g + 1], b2 = bs[4 * g + 2], b3 = bs[4 * g + 3];
        const float c0 = sc[4 * g], c1 = sc[4 * g + 1], c2 = sc[4 * g + 2], c3 = sc[4 * g + 3];
        int i1 = 0; float v1 = b0, s1 = c0;
        if (b1 > v1) { v1 = b1; i1 = 1; s1 = c1; } if (b2 > v1) { v1 = b2; i1 = 2; s1 = c2; } if (b3 > v1) { v1 = b3; i1 = 3; s1 = c3; }
        int i2 = -1; float v2 = -3.0e38f, s2 = 0.f;
        if (i1 != 0 && b0 > v2) { v2 = b0; i2 = 0; s2 = c0; } if (i1 != 1 && b1 > v2) { v2 = b1; i2 = 1; s2 = c1; }
        if (i1 != 2 && b2 > v2) { v2 = b2; i2 = 2; s2 = c2; } if (i1 != 3 && b3 > v2) { v2 = b3; i2 = 3; s2 = c3; }
        const float gs = v1 + v2;
        if (gs > bestGS) { bestGS = gs; E1 = 4 * g + i1; E2 = 4 * g + i2; S1 = s1; S2 = s2; }
      }
      if (lane == 0) { const float inv = 1.f / (S1 + S2); selE[lrow * 2] = E1; selE[lrow * 2 + 1] = E2; selG[lrow * 2] = S1 * inv; selG[lrow * 2 + 1] = S2 * inv; }
  };
  for (int chunk = blockIdx.x; chunk < NTOK / 64; chunk += gridDim.x) {
    u32x2 ha[8], hb[8];
    const long row0 = (long)chunk * 64 + wave * 8;
    load_yrow(hsrc + row0 * 2048, lane, ha); load_yrow(hsrc + (row0 + 1) * 2048, lane, hb);
#pragma unroll 1
    for (int i = 0; i < 8; i += 2) {
      const int lrow = wave * 8 + i; const long row = row0 + i;
      f32x4 va[8], vb[8];
      yrow_to_f32(ha, va); yrow_to_f32(hb, vb);
      if (i < 6) { load_yrow(hsrc + (row + 2) * 2048, lane, ha); load_yrow(hsrc + (row + 3) * 2048, lane, hb); }
      const float ra = norm_row(va, gvec, lane), rbv = norm_row(vb, gvec, lane);
      if (lane == 0) { rstd[row] = ra; rstd[row + 1] = rbv; }
      f32x2 tab[8][4];
      const LAS float* wlo = wr + 4 * lane; const LAS float* whi = wr + 8 * 2048 + 4 * lane;
      asm volatile("" : "+v"(wlo), "+v"(whi));
#pragma unroll
      for (int k = 0; k < 8; ++k) { tab[k][0] = (f32x2){va[k].x, vb[k].x}; tab[k][1] = (f32x2){va[k].y, vb[k].y}; tab[k][2] = (f32x2){va[k].z, vb[k].z}; tab[k][3] = (f32x2){va[k].w, vb[k].w}; }
      float sa[16], sb[16];
#pragma unroll
      for (int e = 0; e < 16; ++e) {
        f32x2 s0 = {0.f, 0.f}, s1 = {0.f, 0.f};
#pragma unroll
        for (int k = 0; k < 8; ++k) { const f32x4 wv = *(const LAS f32x4*)((e < 8 ? wlo : whi) + (e & 7) * 2048 + 256 * k);
          s0 += tab[k][0] * (f32x2){wv.x, wv.x}; s1 += tab[k][1] * (f32x2){wv.y, wv.y}; s0 += tab[k][2] * (f32x2){wv.z, wv.z}; s1 += tab[k][3] * (f32x2){wv.w, wv.w}; }
        s0 += s1;
        sa[e] = s0.x; sb[e] = s0.y;
        if ((e & 1) == 1) __builtin_amdgcn_sched_barrier(0);
      }
      finish(sa, lrow); finish(sb, lrow + 1);
    }
    __syncthreads();
    if (wave == 0) {
      const int e1 = selE[lane * 2], e2 = selE[lane * 2 + 1];
      const unsigned long long lt = (1ull << lane) - 1ull;
      unsigned pos1 = 0, pos2 = 0;
#pragma unroll
      for (int e = 0; e < 16; ++e) {
        const unsigned long long b0 = __ballot(e1 == e), b1 = __ballot(e2 == e);
        const unsigned n0 = __popcll(b0), tot = n0 + __popcll(b1);
        unsigned base = 0;
        if (tot) { if (lane == 0) base = atomicAdd(cnt + e * 64, tot); base = __builtin_amdgcn_readfirstlane(base); }
        if (e1 == e) pos1 = base + __popcll(b0 & lt);
        if (e2 == e) pos2 = base + n0 + __popcll(b1 & lt);
      }
      const unsigned tok = chunk * 64 + lane;
      elist[e1 * 16384 + pos1] = tok * 2u; elist[e2 * 16384 + pos2] = tok * 2u + 1u;
      tokg[tok * 2] = selG[lane * 2]; tokg[tok * 2 + 1] = selG[lane * 2 + 1];
    }
    __syncthreads();
  }
}

constexpr int AL_V = 0, AL_KN = 65536, AL_KR = 114688, AL_WS = 139264;
constexpr int AL_PF = 141312;
#define SBAR() __builtin_amdgcn_sched_barrier(0)
__device__ __forceinline__ int crow(int r, int hi) { return (r & 3) + 8 * (r >> 2) + 4 * hi; }
__device__ __forceinline__ int v_st(int k, int c) { const int kk = (k & ~0xC) | ((k & 4) << 1) | ((k & 8) >> 1); return ((kk >> 3) * 4 + (c >> 5)) * 512 + ((kk & 7) * 32 + (c & 31)) * 2; }
__device__ __forceinline__ int v_rd_base(int lane) { return ((lane & 3) << 3) | (((lane >> 2) & 3) << 6) | (((lane >> 4) & 1) << 5) | (((lane >> 5) & 1) << 8); }
constexpr int v_rd_off(int d0, int ks, int half) { return d0 * 512 + ks * 4096 + half * 2048; }
template <int OFF> __device__ __forceinline__ s16x4 tr_read(int vb) {
  s16x4 r; asm volatile("ds_read_b64_tr_b16 %0, %1 offset:%2" : "=&v"(r) : "v"(vb), "i"(OFF) : "memory"); return r;
}
template <int D0> __device__ __forceinline__ void pv_one(f32x16& od, int vb, bf16x8 pa0, bf16x8 pa1, bf16x8 pa2, bf16x8 pa3) {
  const s16x4 l0 = tr_read<v_rd_off(D0, 0, 0)>(vb), h0 = tr_read<v_rd_off(D0, 0, 1)>(vb), l1 = tr_read<v_rd_off(D0, 1, 0)>(vb), h1 = tr_read<v_rd_off(D0, 1, 1)>(vb);
  const s16x4 l2 = tr_read<v_rd_off(D0, 2, 0)>(vb), h2 = tr_read<v_rd_off(D0, 2, 1)>(vb), l3 = tr_read<v_rd_off(D0, 3, 0)>(vb), h3 = tr_read<v_rd_off(D0, 3, 1)>(vb);
  asm volatile("s_waitcnt lgkmcnt(0)" ::: "memory"); SBAR();
#define PKV(L, H) (bf16x8){L[0], L[1], L[2], L[3], H[0], H[1], H[2], H[3]}
  od = __builtin_amdgcn_mfma_f32_32x32x16_bf16(pa0, PKV(l0, h0), od, 0, 0, 0);
  od = __builtin_amdgcn_mfma_f32_32x32x16_bf16(pa1, PKV(l1, h1), od, 0, 0, 0);
  od = __builtin_amdgcn_mfma_f32_32x32x16_bf16(pa2, PKV(l2, h2), od, 0, 0, 0);
  od = __builtin_amdgcn_mfma_f32_32x32x16_bf16(pa3, PKV(l3, h3), od, 0, 0, 0);
#undef PKV
}
#define PK4(P, BASE, OUT) do { unsigned a0 = cvtpk(P[BASE + 0], P[BASE + 1]), a1 = cvtpk(P[BASE + 2], P[BASE + 3]);   \
    unsigned b0 = cvtpk(P[BASE + 4], P[BASE + 5]), b1 = cvtpk(P[BASE + 6], P[BASE + 7]);                              \
    auto r0 = __builtin_amdgcn_permlane32_swap(a0, b0, false, false); auto r1 = __builtin_amdgcn_permlane32_swap(a1, b1, false, false); \
    u32x4 w_ = {r0[0], r1[0], r0[1], r1[1]}; OUT = *reinterpret_cast<bf16x8*>(&w_); } while (0)

template <int DQK, bool MASK, bool BIAS>
__device__ __forceinline__ void attn_core(LAS unsigned char* lds, const bf16_t* qrow, const bf16_t* Kb, long kstride, const bf16_t* Vb, long vstride,
                                          int t0, int t1, int qi, int W, int qmin, int qmax, float C, float sl2, f32x16 (&o)[4], float& lsum) {
  const int tid = TID(), lane = tid & 63, r32 = lane & 31, hi = lane >> 5;
  constexpr int ND = DQK / 16;
  bf16x8 qr[ND];
#pragma unroll
  for (int d = 0; d < 4; ++d) o[d] = f32x16{};
  float ls = 0.f;
  const int w = __builtin_amdgcn_readfirstlane(tid >> 6);
  int koff[2], voff[2], roff = 0;
#pragma unroll
  for (int i = 0; i < 2; ++i) {
    const int s_ = (w * 2 + i) * 64 + lane;
    { const int row = s_ >> 4, c = (s_ & 15) ^ (row & 15); koff[i] = row * (int)kstride + c * 8; }
    { const int sub = s_ >> 5, kk = (sub >> 2) * 8 + ((s_ & 31) >> 2), k = (kk & ~0xC) | ((kk & 4) << 1) | ((kk & 8) >> 1), c = (sub & 3) * 32 + (s_ & 3) * 8; voff[i] = k * (int)vstride + c; }
  }
  if (DQK == 192) { const int s_ = w * 64 + lane, row = s_ >> 3, c = (s_ & 7) ^ ((row >> 1) & 7); roff = row * (int)kstride + 128 + c * 8; }
  const int kn_rd = r32 * 256, kn_x = (r32 & 15) << 4, kr_rd = r32 * 128, kr_x = (r32 >> 1) & 7;
  const int vb0 = (int)(unsigned long)(lds + AL_V) + v_rd_base(lane);
#define A_STAGE(t) do { const int i3_ = ((t) - t0) % 3, i4_ = ((t) - t0) & 3; const bf16_t* kt_ = Kb + (long)(t) * 64 * kstride; const bf16_t* vt_ = Vb + (long)(t) * 64 * vstride; \
    _Pragma("unroll") for (int i = 0; i < 2; ++i) { GLDS16(kt_ + koff[i], lds + AL_KN + i3_ * 16384 + (w * 2 + i) * 1024); GLDS16(vt_ + voff[i], lds + AL_V + i4_ * 16384 + (w * 2 + i) * 1024); } \
    if (DQK == 192) GLDS16(kt_ + roff, lds + AL_KR + i3_ * 8192 + w * 1024); } while (0)
  constexpr int NPT = (DQK == 192) ? 5 : 4;
  const bool lag = w >= 4;
  bf16x8 pp0, pp1, pp2, pp3; bool pend = false; int vprev = 0;
  if (t0 < t1) A_STAGE(t0);
  if (t0 + 1 < t1) A_STAGE(t0 + 1);
#pragma unroll
  for (int d0 = 0; d0 < ND; ++d0) qr[d0] = *(const bf16x8*)(qrow + d0 * 16 + hi * 8);
  for (int t = t0; t < t1; ++t) {
    if (t + 1 < t1) { if (NPT == 5) asm volatile("s_waitcnt vmcnt(5)" ::: "memory"); else asm volatile("s_waitcnt vmcnt(4)" ::: "memory"); }
    else asm volatile("s_waitcnt vmcnt(0)" ::: "memory");
    __builtin_amdgcn_s_barrier();
    asm volatile("" ::: "memory");
    if (t + 2 < t1) A_STAGE(t + 2);
    const int kbuf = (t - t0) % 3, vbuf = (t - t0) & 3;
    if (pend) { const int vb = vb0 + vprev * 16384;
      pv_one<0>(o[0], vb, pp0, pp1, pp2, pp3); pv_one<1>(o[1], vb, pp0, pp1, pp2, pp3); pv_one<2>(o[2], vb, pp0, pp1, pp2, pp3); pv_one<3>(o[3], vb, pp0, pp1, pp2, pp3); pend = false; }
    bool active = true, full = true;
    if (MASK) { active = (t * 64 <= qmax) && (t * 64 + 63 >= qmin - W); full = (t * 64 + 63 <= qmin) && (t * 64 >= qmax - W); }
    if (active) {
      f32x16 p0 = f32x16{}, p1 = f32x16{};
      const LAS unsigned char* kn = lds + AL_KN + kbuf * 16384 + kn_rd;
#pragma unroll
      for (int d0 = 0; d0 < 8; ++d0) {
        const int cb = (d0 * 32 + hi * 16) ^ kn_x;
        const bf16x8 b0 = *(const LAS bf16x8*)(kn + cb), b1 = *(const LAS bf16x8*)(kn + 8192 + cb);
        p0 = __builtin_amdgcn_mfma_f32_32x32x16_bf16(b0, qr[d0], p0, 0, 0, 0);
        p1 = __builtin_amdgcn_mfma_f32_32x32x16_bf16(b1, qr[d0], p1, 0, 0, 0);
      }
      if (DQK == 192) {
        const LAS unsigned char* kr = lds + AL_KR + kbuf * 8192 + kr_rd;
#pragma unroll
        for (int d0 = 8; d0 < ND; ++d0) {
          const int cb = ((2 * (d0 - 8) + hi) ^ kr_x) << 4;
          const bf16x8 b0 = *(const LAS bf16x8*)(kr + cb), b1 = *(const LAS bf16x8*)(kr + 4096 + cb);
          p0 = __builtin_amdgcn_mfma_f32_32x32x16_bf16(b0, qr[d0], p0, 0, 0, 0);
          p1 = __builtin_amdgcn_mfma_f32_32x32x16_bf16(b1, qr[d0], p1, 0, 0, 0);
        }
      }
      const float tb = BIAS ? sl2 * (float)(t * 64 + 4 * hi - qi) : 0.f;
      const int dd = qi - t * 64 - 4 * hi;
      if (!MASK || full) {
#pragma unroll
        for (int r = 0; r < 16; ++r) {
          const int c_r = (r & 3) + 8 * (r >> 2);
          const float x0 = fmaf(p0[r], C, BIAS ? fmaf(sl2, (float)c_r, tb) : 0.f), x1 = fmaf(p1[r], C, BIAS ? fmaf(sl2, (float)(c_r + 32), tb) : 0.f);
          p0[r] = __builtin_amdgcn_exp2f(x0); p1[r] = __builtin_amdgcn_exp2f(x1); ls += p0[r] + p1[r];
        }
      } else {
#pragma unroll
        for (int r = 0; r < 16; ++r) {
          const int c_r = (r & 3) + 8 * (r >> 2);
          float x0 = fmaf(p0[r], C, BIAS ? fmaf(sl2, (float)c_r, tb) : 0.f), x1 = fmaf(p1[r], C, BIAS ? fmaf(sl2, (float)(c_r + 32), tb) : 0.f);
          x0 = ((unsigned)(dd - c_r) <= (unsigned)W) ? x0 : -1.0e30f; x1 = ((unsigned)(dd - c_r - 32) <= (unsigned)W) ? x1 : -1.0e30f;
          p0[r] = __builtin_amdgcn_exp2f(x0); p1[r] = __builtin_amdgcn_exp2f(x1); ls += p0[r] + p1[r];
        }
      }
      PK4(p0, 0, pp0); PK4(p0, 8, pp1); PK4(p1, 0, pp2); PK4(p1, 8, pp3);
      if (lag) { pend = true; vprev = vbuf; }
      else { const int vb = vb0 + vbuf * 16384;
        pv_one<0>(o[0], vb, pp0, pp1, pp2, pp3); pv_one<1>(o[1], vb, pp0, pp1, pp2, pp3); pv_one<2>(o[2], vb, pp0, pp1, pp2, pp3); pv_one<3>(o[3], vb, pp0, pp1, pp2, pp3); }
    }
  }
  if (pend) { const int vb = vb0 + vprev * 16384;
    pv_one<0>(o[0], vb, pp0, pp1, pp2, pp3); pv_one<1>(o[1], vb, pp0, pp1, pp2, pp3); pv_one<2>(o[2], vb, pp0, pp1, pp2, pp3); pv_one<3>(o[3], vb, pp0, pp1, pp2, pp3); }
#undef A_STAGE
  { auto rr2 = __builtin_amdgcn_permlane32_swap(__float_as_uint(ls), __float_as_uint(ls), false, false);
    lsum = __uint_as_float(rr2[0]) + __uint_as_float(rr2[1]); }
}
__device__ __forceinline__ void attn_row_l(LAS float* wsc, float l, int r32, int hi, float (&lr)[16]) {
  if (hi == 0) wsc[r32] = l;
#pragma unroll
  for (int r = 0; r < 16; ++r) lr[r] = wsc[crow(r, hi)];
}

#define OPAQUE2(a, b) int a##_o = a, b##_o = b; asm volatile("" : "+v"(a##_o), "+v"(b##_o));
__device__ __forceinline__ bf16_t f2bf(float x) { return (bf16_t)(cvtpk(x, x) & 0xffffu); }
constexpr float C128 = 0.08838834764831845f * LOG2E, C192 = 0.07216878364870323f * LOG2E;

__device__ __forceinline__ void attn_item_mla(PP p, LAS unsigned char* lds, int b, int h, int qb) {
  unsigned char* ws = p->ws;
  const int tid = TID(), lane = tid & 63, w = __builtin_amdgcn_readfirstlane(tid >> 6), r32 = lane & 31, hi = lane >> 5;
  const int q0 = qb * 256 + 32 * w;
  const bf16_t* qrow = (const bf16_t*)(ws + PT_QB) + ((long)b * SEQ + q0 + r32) * 1536 + h * 192;
  const bf16_t* Kb = (const bf16_t*)(ws + PT_KB) + (long)b * SEQ * 1536 + h * 192;
  const bf16_t* Vb = (const bf16_t*)(ws + PT_VB) + (long)b * SEQ * 1024 + h * 128;
  f32x16 o[4]; float l;
  __syncthreads();
  attn_core<192, true, false>(lds, qrow, Kb, 1536, Vb, 1024, 0, (qb + 1) * 4, q0 + r32, 1 << 30, q0, q0 + 31, C192, 0.f, o, l);
  OPAQUE2(r32, hi);
  float lr[16]; attn_row_l((LAS float*)(lds + AL_WS + w * 256), l, r32_o, hi_o, lr);
  bf16_t* dst = (bf16_t*)(ws + ACT) + ((long)b * SEQ + q0) * 2048 + 1024 + h * 128 + r32_o;
#pragma unroll
  for (int r = 0; r < 16; ++r) {
    const float inv = 1.f / lr[r]; const long ro = (long)crow(r, hi_o) * 2048;
#pragma unroll
    for (int d0 = 0; d0 < 4; ++d0) dst[ro + d0 * 32] = f2bf(o[d0][r] * inv);
  }
}
__device__ __forceinline__ void attn_item_dil(PP p, LAS unsigned char* lds, int pat, int b, int h, int strm, int qb) {
  unsigned char* ws = p->ws;
  const int tid = TID(), lane = tid & 63, w = __builtin_amdgcn_readfirstlane(tid >> 6), r32 = lane & 31, hi = lane >> 5;
  const int dil = pat == 0 ? 1 : (pat == 1 ? 4 : 16);
  const int q0 = qb * 256 + 32 * w, qi = q0 + r32;
  const long tb = (long)b * SEQ + strm;
  const bf16_t* qrow = (const bf16_t*)(ws + P_QA) + (tb + (long)qi * dil) * 1024 + h * 128;
  const bf16_t* Kb = (const bf16_t*)(ws + P_KA) + tb * 1024 + h * 128;
  const bf16_t* Vb = (const bf16_t*)(ws + P_VA) + tb * 1024 + h * 128;
  const float sl2 = __builtin_amdgcn_exp2f(-(float)(h + 1)) * (float)dil * LOG2E;
  const int t0 = qb * 4 - 2 > 0 ? qb * 4 - 2 : 0;
  f32x16 o[4]; float l;
  __syncthreads();
  attn_core<128, true, true>(lds, qrow, Kb, (long)dil * 1024, Vb, (long)dil * 1024, t0, qb * 4 + 4, qi, 128, q0, q0 + 31, C128, sl2, o, l);
  OPAQUE2(r32, hi);
  if (pat != 0) {
    float* la = (float*)(ws + S_LA) + (long)(pat - 1) * NTOK * 8;
    bf16_t* pa = (bf16_t*)(ws + PT_PA) + (long)(pat - 1) * NTOK * 1024;
    if (hi_o == 0) la[(tb + (long)(q0 + r32_o) * dil) * 8 + h] = l;
#pragma unroll
    for (int r = 0; r < 16; ++r) {
      bf16_t* d = pa + (tb + (long)(q0 + crow(r, hi_o)) * dil) * 1024 + h * 128 + r32_o;
#pragma unroll
      for (int d0 = 0; d0 < 4; ++d0) d[d0 * 32] = f2bf(o[d0][r]);
    }
  } else {
    float lr[16]; attn_row_l((LAS float*)(lds + AL_WS + w * 256), l, r32_o, hi_o, lr);
    const float* la = (const float*)(ws + S_LA);
    const bf16_t* pa = (const bf16_t*)(ws + PT_PA);
    bf16_t* dst = (bf16_t*)(ws + ACT);
#pragma unroll
    for (int r = 0; r < 16; ++r) {
      const long tok = tb + q0 + crow(r, hi_o);
      const float lt = lr[r] + la[tok * 8 + h] + la[(long)NTOK * 8 + tok * 8 + h];
      const float inv = 1.f / lt;
      const bf16_t* p1 = pa + tok * 1024 + h * 128 + r32_o; const bf16_t* p2 = p1 + (long)NTOK * 1024;
#pragma unroll
      for (int d0 = 0; d0 < 4; ++d0) dst[tok * 2048 + h * 128 + d0 * 32 + r32_o] = f2bf((o[d0][r] + bf2f(p1[d0 * 32]) + bf2f(p2[d0 * 32])) * inv);
    }
  }
}
__device__ __forceinline__ int moba_list_off(int j) { return 256 * (31 * j - (j * (j - 1)) / 2); }
__device__ __forceinline__ void attn_item_moba_sel(PP p, LAS unsigned char* lds, int bh, int j, int chunk, int cnt) {
  unsigned char* ws = p->ws;
  const int tid = TID(), lane = tid & 63, w = __builtin_amdgcn_readfirstlane(tid >> 6), r32 = lane & 31, hi = lane >> 5;
  const int b = bh >> 4, h = bh & 15;
  const int idx = chunk * 256 + 32 * w + r32; const bool valid = idx < cnt;
  const unsigned ent = ((const unsigned*)(ws + S_MLIST))[(long)bh * 126976 + moba_list_off(j) + (valid ? idx : cnt - 1)];
  const int s = (int)(ent & 8191u), slot = (int)(ent >> 13);
  const long tokq = (long)b * SEQ + s;
  const bf16_t* qrow = (const bf16_t*)(ws + P_Q1) + tokq * 2048 + h * 128;
  const bf16_t* Kb = (const bf16_t*)(ws + P_K1) + (long)b * SEQ * 2048 + h * 128;
  const bf16_t* Vb = (const bf16_t*)(ws + P_V1) + (long)b * SEQ * 2048 + h * 128;
  const float sl2 = __builtin_amdgcn_exp2f(-0.5f * (float)(h + 1)) * LOG2E;
  f32x16 o[4]; float l;
  __syncthreads();
  attn_core<128, false, true>(lds, qrow, Kb, 2048, Vb, 2048, 4 * j, 4 * j + 4, s, 0, 0, 0, C128, sl2, o, l);
  OPAQUE2(r32, hi);
  LAS int* wsi = (LAS int*)(lds + AL_WS + w * 256) + 32;
  if (hi_o == 0) { wsi[r32_o] = valid ? (int)(tokq * 4 + slot) : -1; if (valid) ((float*)(ws + S_LSEL))[((long)slot * NTOK + tokq) * 16 + h] = l; }
  bf16_t* psel = (bf16_t*)(ws + PT_PSEL);
#pragma unroll
  for (int r = 0; r < 16; ++r) {
    const int info = wsi[crow(r, hi_o)];
    if (info >= 0) {
      bf16_t* d = psel + (((long)(info & 3) * NTOK + (info >> 2)) * 16 + h) * 128 + r32_o;
#pragma unroll
      for (int d0 = 0; d0 < 4; ++d0) d[d0 * 32] = f2bf(o[d0][r]);
    }
  }
}
__device__ __forceinline__ void attn_item_moba_own(PP p, LAS unsigned char* lds, int b, int h, int i) {
  unsigned char* ws = p->ws;
  const int tid = TID(), lane = tid & 63, w = __builtin_amdgcn_readfirstlane(tid >> 6), r32 = lane & 31, hi = lane >> 5;
  const int q0 = i * 256 + 32 * w, qi = q0 + r32;
  const bf16_t* qrow = (const bf16_t*)(ws + P_Q1) + ((long)b * SEQ + qi) * 2048 + h * 128;
  const bf16_t* Kb = (const bf16_t*)(ws + P_K1) + (long)b * SEQ * 2048 + h * 128;
  const bf16_t* Vb = (const bf16_t*)(ws + P_V1) + (long)b * SEQ * 2048 + h * 128;
  const float sl2 = __builtin_amdgcn_exp2f(-0.5f * (float)(h + 1)) * LOG2E;
  f32x16 o[4]; float l;
  __syncthreads();
  attn_core<128, true, true>(lds, qrow, Kb, 2048, Vb, 2048, 4 * i, 4 * i + 4, qi, 1 << 30, q0, q0 + 31, C128, sl2, o, l);
  OPAQUE2(r32, hi);
  float lr[16]; attn_row_l((LAS float*)(lds + AL_WS + w * 256), l, r32_o, hi_o, lr);
  const int nv = i < 3 ? i : 3;
  const float* lsel = (const float*)(ws + S_LSEL); const bf16_t* psel = (const bf16_t*)(ws + PT_PSEL);
  bf16_t* dst = (bf16_t*)(ws + ACT);
#pragma unroll
  for (int rg = 0; rg < 8; ++rg) {
    float lv[2][3]; unsigned short pv[2][3][4];
#pragma unroll
    for (int rr = 0; rr < 2; ++rr) {
      const long tok = (long)b * SEQ + q0 + crow(2 * rg + rr, hi_o);
#pragma unroll
      for (int sl = 0; sl < 3; ++sl) {
        const long ss = sl < nv ? sl : 0;
        lv[rr][sl] = lsel[(ss * NTOK + tok) * 16 + h];
        const bf16_t* ps = psel + ((ss * NTOK + tok) * 16 + h) * 128 + r32_o;
        pv[rr][sl][0] = ps[0]; pv[rr][sl][1] = ps[32]; pv[rr][sl][2] = ps[64]; pv[rr][sl][3] = ps[96];
      }
    }
#pragma unroll
    for (int rr = 0; rr < 2; ++rr) {
      const int r = 2 * rg + rr;
      const long tok = (long)b * SEQ + q0 + crow(r, hi_o);
      float lt = lr[r]; float a0 = o[0][r], a1 = o[1][r], a2 = o[2][r], a3 = o[3][r];
#pragma unroll
      for (int sl = 0; sl < 3; ++sl) {
        const bool on = sl < nv;
        lt += on ? lv[rr][sl] : 0.f;
        a0 += on ? bf2f(pv[rr][sl][0]) : 0.f; a1 += on ? bf2f(pv[rr][sl][1]) : 0.f; a2 += on ? bf2f(pv[rr][sl][2]) : 0.f; a3 += on ? bf2f(pv[rr][sl][3]) : 0.f;
      }
      const float inv = 1.f / lt; bf16_t* d = dst + tok * 2048 + h * 128 + r32_o;
      d[0] = f2bf(a0 * inv); d[32] = f2bf(a1 * inv); d[64] = f2bf(a2 * inv); d[96] = f2bf(a3 * inv);
    }
  }
}

__device__ __forceinline__ void phase_moba_gate(PP p, LAS unsigned char* lds) {
  unsigned char* ws = p->ws;
  LAS float* km = (LAS float*)lds;
  const int tid = TID(), lane = tid & 63;
  const float* kpart = (const float*)(ws + S_KPART);
  unsigned* mcnt = (unsigned*)(ws + S_CTL) + CTL_MCNT;
  unsigned* mlist = (unsigned*)(ws + S_MLIST);
  for (int k_ = blockIdx.x; k_ < 2 * 31 * 8; k_ += gridDim.x) {
    const int it = (gridDim.x == 256 && k_ >= 256) ? 751 - k_ : k_;
    const int b = it / 248, rem = it % 248, i = 1 + rem / 8, hp = rem % 8;
    __syncthreads();
    for (int idx = tid; idx < 2 * i * 128; idx += 512) {
      const int hh = idx / (i * 128), r2 = idx - hh * i * 128, j = r2 >> 7, d = r2 & 127, h = 2 * hp + hh;
      const float* kp = kpart + ((long)(b * 256 + 8 * j) * 16 + h) * 128 + d;
      float s = 0.f;
#pragma unroll
      for (int c = 0; c < 8; ++c) s += kp[c * 16 * 128];
      km[(hh * 32 + j) * 128 + d] = s * (1.f / 256.f);
    }
    __syncthreads();
    const int q = tid & 255, hh = tid >> 8, h = 2 * hp + hh, bh = b * 16 + h;
    const bf16_t* qp = (const bf16_t*)(ws + P_Q1) + ((long)b * SEQ + i * 256 + q) * 2048 + h * 128;
    float qf[128];
#pragma unroll
    for (int c = 0; c < 16; ++c) {
      const u32x4 u = *(const u32x4*)(qp + 8 * c);
      qf[8 * c + 0] = bflo(u.x); qf[8 * c + 1] = bfhi(u.x); qf[8 * c + 2] = bflo(u.y); qf[8 * c + 3] = bfhi(u.y);
      qf[8 * c + 4] = bflo(u.z); qf[8 * c + 5] = bfhi(u.z); qf[8 * c + 6] = bflo(u.w); qf[8 * c + 7] = bfhi(u.w);
    }
    float v0 = -3.0e38f, v1 = -3.0e38f, v2 = -3.0e38f; int i0 = 0, i1 = 0, i2 = 0;
    for (int j = 0; j < i; ++j) {
      const LAS float* kj = km + (hh * 32 + j) * 128;
      float g0 = 0.f, g1 = 0.f, g2 = 0.f, g3 = 0.f;
#pragma unroll
      for (int d4 = 0; d4 < 32; ++d4) { const f32x4 kv = *(const LAS f32x4*)(kj + 4 * d4); g0 = fmaf(qf[4 * d4], kv.x, g0); g1 = fmaf(qf[4 * d4 + 1], kv.y, g1); g2 = fmaf(qf[4 * d4 + 2], kv.z, g2); g3 = fmaf(qf[4 * d4 + 3], kv.w, g3); }
      const float g = (g0 + g1) + (g2 + g3);
      if (g > v0) { v2 = v1; i2 = i1; v1 = v0; i1 = i0; v0 = g; i0 = j; }
      else if (g > v1) { v2 = v1; i2 = i1; v1 = g; i1 = j; }
      else if (g > v2) { v2 = g; i2 = j; }
    }
    const int nv = i < 3 ? i : 3;
    const unsigned qs = (unsigned)(i * 256 + q);
    const unsigned long long lt = (1ull << lane) - 1ull;
    unsigned my_tot = 0;
    for (int j = 0; j < i; ++j) {
      const unsigned tot = __popcll(__ballot(i0 == j)) + __popcll(__ballot(nv > 1 && i1 == j)) + __popcll(__ballot(nv > 2 && i2 == j));
      if (lane == j) my_tot = tot;
    }
    unsigned my_base = 0;
    if (my_tot) my_base = atomicAdd(mcnt + bh * 32 + lane, my_tot);
    for (int j = 0; j < i; ++j) {
      const unsigned long long m0 = __ballot(i0 == j), m1 = __ballot(nv > 1 && i1 == j), m2 = __ballot(nv > 2 && i2 == j);
      const unsigned n0 = __popcll(m0), n1 = __popcll(m1);
      if ((m0 | m1 | m2) == 0ull) continue;
      const unsigned base = __builtin_amdgcn_readlane(my_base, j);
      unsigned* L = mlist + (long)bh * 126976 + moba_list_off(j) + base;
      if (i0 == j) L[__popcll(m0 & lt)] = qs;
      if (nv > 1 && i1 == j) L[n0 + __popcll(m1 & lt)] = qs | (1u << 13);
      if (nv > 2 && i2 == j) L[n0 + n1 + __popcll(m2 & lt)] = qs | (2u << 13);
    }
  }
}
__device__ __forceinline__ void phase_moba_sel(PP p, LAS unsigned char* lds) {
  const int tid = TID(), lane = tid & 63, wave = tid >> 6;
  LAS int* pf = (LAS int*)(lds + AL_PF);
  LAS int* wt = pf + 1032;
  const unsigned* mcnt = (const unsigned*)(p->ws + S_CTL) + CTL_MCNT;
  const int a = ((int)mcnt[2 * tid] + 255) >> 8, b2 = ((int)mcnt[2 * tid + 1] + 255) >> 8, s = a + b2;
  int v = s;
#pragma unroll
  for (int o = 1; o < 64; o <<= 1) { const int t = __shfl_up(v, o); if (lane >= o) v += t; }
  if (lane == 63) wt[wave] = v;
  __syncthreads();
  int woff = 0;
  for (int k = 0; k < wave; ++k) woff += wt[k];
  const int excl = woff + v - s;
  pf[2 * tid] = excl; pf[2 * tid + 1] = excl + a;
  if (tid == 511) pf[1024] = excl + s;
  __syncthreads();
  const int total = pf[1024];
  for (int it = blockIdx.x; it < total; it += gridDim.x) {
    int lo = 0, hi = 1024;
    while (hi - lo > 1) { const int mid = (lo + hi) >> 1; if (pf[mid] <= it) lo = mid; else hi = mid; }
    attn_item_moba_sel(p, lds, lo >> 5, lo & 31, it - pf[lo], (int)mcnt[lo]);
  }
}

__device__ __forceinline__ void phase_prep0(PP p, LAS unsigned char* lds) {
  unsigned char* ws = p->ws;
  const int tid = TID(), lane = tid & 63, wave = tid >> 6;
  run_tjobs<0>(p, lds, 0, TJ0_DENSE, 0);
  const long gt = (long)blockIdx.x * 512 + tid, GT = (long)gridDim.x * 512;
  { for (long i = gt; i < 64 * 192 * 4; i += GT) { const long c = i / (192 * 4), r = i % (192 * 4); *(u32x4*)((bf16_t*)(ws + W0_IN) + (c * 4096 + 3904) * 32 + r * 8) = (u32x4){0u, 0u, 0u, 0u}; } }
  { float* rope = (float*)(ws + S_ROPE);
    for (long i = gt; i < 8192 * 32; i += GT) {
      const int pos = (int)(i >> 5), f = (int)(i & 31);
      const double rev = (double)pos * (double)p->inv_freq[f] * 0.15915494309189535;
      const float fr = (float)(rev - floor(rev));
      rope[2 * i] = __builtin_amdgcn_cosf(fr); rope[2 * i + 1] = __builtin_amdgcn_sinf(fr);
    } }
  {
    const long rs = (long)gridDim.x * 8; long row = (long)blockIdx.x * 8 + wave;
    f32x4 v[8], vn[8];
    if (row < NTOK) load_row(p->in[0] + row * 2048, lane, v);
    for (; row < NTOK; row += rs) {
      if (row + rs < NTOK) load_row(p->in[0] + (row + rs) * 2048, lane, vn);
      norm_row(v, p->in[1], lane); store_row_bf16((bf16_t*)(ws + ACT) + row * 2048, lane, v);
#pragma unroll
      for (int i = 0; i < 8; ++i) v[i] = vn[i];
    }
  }
}
__device__ __forceinline__ void phase_prep1(PP p, LAS unsigned char* lds) {
  unsigned char* ws = p->ws;
  const int tid = TID(), lane = tid & 63, wave = tid >> 6;
  run_tjobs<1>(p, lds, TJ1_DENSE + TJ1_GU, TJ1_TOTAL, 0);
  const bf16_t* yb = (const bf16_t*)(ws + P_YB);
  {
    const long rs = (long)gridDim.x * 8; long row = (long)blockIdx.x * 8 + wave;
    const bf16_t* hsrc = (const bf16_t*)(ws + PT_H);
    f32x4 v[8]; u32x2 hw[8], hwn[8]; u32x2 y0[8], y1[8], y0n[8], y1n[8];
    if (row < NTOK) { load_yrow(hsrc + row * 2048, lane, hw); load_yrow(yb + row * 2048, lane, y0); load_yrow(yb + ((long)NTOK + row) * 2048, lane, y1); }
    for (; row < NTOK; row += rs) {
      const long rn = row + rs;
      if (rn < NTOK) { load_yrow(hsrc + rn * 2048, lane, hwn); load_yrow(yb + rn * 2048, lane, y0n); load_yrow(yb + ((long)NTOK + rn) * 2048, lane, y1n); }
      yrow_to_f32(hw, v); add_yrow(y0, v); add_yrow(y1, v);
      store_row_f32(p->out + row * 2048, lane, v);
      norm_row(v, p->in[1] + 2048, lane); store_row_bf16((bf16_t*)(ws + ACT) + row * 2048, lane, v);
#pragma unroll
      for (int i = 0; i < 8; ++i) { hw[i] = hwn[i]; y0[i] = y0n[i]; y1[i] = y1n[i]; }
    }
  }
}
__device__ __forceinline__ void phase_final(PP p) {
  const int lane = TID() & 63, wave = TID() >> 6;
  const bf16_t* yb = (const bf16_t*)(p->ws + P_YB);
  const long rs = (long)gridDim.x * 8; long row = (long)blockIdx.x * 8 + wave;
  const bf16_t* hsrc = (const bf16_t*)(p->ws + PT_H);
  f32x4 v[8]; u32x2 hw[8], hwn[8]; u32x2 y0[8], y1[8], y0n[8], y1n[8];
  if (row < NTOK) { load_yrow(hsrc + row * 2048, lane, hw); load_yrow(yb + row * 2048, lane, y0); load_yrow(yb + ((long)NTOK + row) * 2048, lane, y1); }
  for (; row < NTOK; row += rs) {
    const long rn = row + rs;
    if (rn < NTOK) { load_yrow(hsrc + rn * 2048, lane, hwn); load_yrow(yb + rn * 2048, lane, y0n); load_yrow(yb + ((long)NTOK + rn) * 2048, lane, y1n); }
    yrow_to_f32(hw, v); add_yrow(y0, v); add_yrow(y1, v);
    store_row_f32(p->out + row * 2048, lane, v);
#pragma unroll
    for (int i = 0; i < 8; ++i) { hw[i] = hwn[i]; y0[i] = y0n[i]; y1[i] = y1n[i]; }
  }
}

__device__ __forceinline__ void phase_attn0_mla(PP p, LAS unsigned char* lds) {
  for (int k = blockIdx.x; k < 512; k += gridDim.x) { const int s = k < 256 ? k : 767 - k, qb = 31 - s / 16, bh = s % 16; attn_item_mla(p, lds, bh >> 3, bh & 7, qb);
    if (k == (int)blockIdx.x) {
      __syncthreads();
      run_tjobs<0>(p, lds, TJ0_DENSE, TJ0_TOTAL, 0);
      __syncthreads();
    } }
}
__device__ __forceinline__ void phase_attn0_dil(PP p, LAS unsigned char* lds, int first) {
  if (first) { for (int k = blockIdx.x; k < 1024; k += gridDim.x) { const int pat = 1 + k / 512, kk = k % 512, nqb = pat == 1 ? 8 : 2, i32 = kk % 32;
      attn_item_dil(p, lds, pat, kk / 256, (kk / 32) % 8, i32 / nqb, i32 % nqb); } }
  else { for (int k = blockIdx.x; k < 512; k += gridDim.x) attn_item_dil(p, lds, 0, k / 256, (k / 32) % 8, 0, k % 32); }
}
__device__ __forceinline__ void phase_moba_own(PP p, LAS unsigned char* lds) {
  for (int k = blockIdx.x; k < 1024; k += gridDim.x) attn_item_moba_own(p, lds, k / 512, (k / 32) % 16, k % 32);
}
__global__ void __launch_bounds__(512) mega(Params p_arg) {
  PP p = (PP)__builtin_amdgcn_kernarg_segment_ptr();
  extern __shared__ __attribute__((aligned(16))) unsigned char lds_raw[];
  LAS unsigned char* lds = (LAS unsigned char*)lds_raw;
  const int tid = TID();
  if (tid < 4) ((LAS unsigned*)(lds + LDS_MISC))[tid] = 0u;
  __syncthreads();
  XcdBarrier bar; bar.bar = (unsigned*)(p->ws + S_CTL) + CTL_BAR; bar.x = 0; bar.st = (volatile LAS unsigned*)(lds + LDS_MISC);
  if (p->ph_hi - p->ph_lo > 1) bar = xcd_barrier_post((unsigned*)(p->ws + S_CTL) + CTL_BAR, (volatile LAS unsigned*)(lds + LDS_MISC));
  const int lo = p->ph_lo, hi = p->ph_hi;
#ifndef ONLY_PH
#define ONLY_PH -1
#endif
#define IN(k) ((ONLY_PH < 0 || ONLY_PH == (k)) && lo <= (k) && (k) < hi)
#define SEAM(k) do { if ((k) + 1 < hi) xcd_barrier(bar); } while (0)
#define RUN(k, call) do { const int n_ = (p->rep_ph == (k)) ? 2 : 1; for (int r_ = 0; r_ < n_; ++r_) { call; } } while (0)
  if (IN(0)) { RUN(0, phase_prep0(p, lds)); SEAM(0); }
  if (IN(1)) { RUN(1, phase_inproj(p, lds)); SEAM(1); }
  if (IN(2)) { RUN(2, phase_qkvb(p, lds)); SEAM(2); }
  if (IN(3)) { RUN(3, phase_attn0_mla(p, lds)); RUN(30, phase_attn0_dil(p, lds, 1)); SEAM(3); }
  if (IN(4)) { RUN(4, phase_attn0_dil(p, lds, 0)); SEAM(4); }
  if (IN(5)) { RUN(5, phase_outproj(p, lds, (const char*)(p->ws + W0_O), p->in[0], (bf16_t*)(p->ws + PT_H))); SEAM(5); }
  if (IN(6)) { phase_router(p, lds, 0); SEAM(6); }
  if (IN(7)) { phase_moe(p, lds, 0); }
  if (IN(8)) { SEAM(8); }
  if (IN(9)) { RUN(9, phase_prep1(p, lds)); SEAM(9); }
  if (IN(10)) { RUN(10, phase_qkv1(p, lds)); SEAM(10); }
  if (IN(11)) { phase_moba_gate(p, lds); SEAM(11); }
  if (IN(12)) { RUN(12, phase_moba_sel(p, lds)); SEAM(12); }
  if (IN(13)) { RUN(13, phase_moba_own(p, lds)); SEAM(13); }
  if (IN(14)) { RUN(14, phase_outproj(p, lds, (const char*)(p->ws + W1_O), p->out, (bf16_t*)(p->ws + PT_H))); SEAM(14); }
  if (IN(15)) { phase_router(p, lds, 1); SEAM(15); }
  if (IN(16)) { phase_moe(p, lds, 1); }
  if (IN(17)) { SEAM(17); }
  if (IN(18)) { RUN(18, phase_final(p)); }
#undef RUN
#undef IN
#undef SEAM
}

extern "C" void kernel_launch(void* const* d_in, const int* in_sizes, int n_in, void* d_out, int out_size, void* d_ws, size_t ws_size, hipStream_t stream) {
  static int grid = 0;
  if (grid == 0) {
    if (n_in != 22 || in_sizes[0] != NTOK * DM || out_size != NTOK * DM || ws_size < WS_END) {
      fprintf(stderr, "kernel_launch: shape/workspace mismatch: n_in %d in0 %d out %d ws %zu (need %zu)\n", n_in, n_in > 0 ? in_sizes[0] : -1, out_size, ws_size, (size_t)WS_END);
      grid = -1; return; }
    int dev = 0, cus = 0, per_cu = 0;
    if (hipGetDevice(&dev) != hipSuccess || hipDeviceGetAttribute(&cus, hipDeviceAttributeMultiprocessorCount, dev) != hipSuccess) { grid = -1; return; }
    if (hipFuncSetAttribute((const void*)mega, hipFuncAttributeMaxDynamicSharedMemorySize, LDS_BYTES) != hipSuccess) { fprintf(stderr, "kernel_launch: hipFuncSetAttribute failed\n"); grid = -1; return; }
    if (hipOccupancyMaxActiveBlocksPerMultiprocessor(&per_cu, (const void*)mega, 512, LDS_BYTES) != hipSuccess || per_cu < 1) { fprintf(stderr, "kernel_launch: occupancy query says %d\n", per_cu); (void)hipGetLastError(); grid = -1; return; }
    grid = cus;
  }
  if (grid < 0) return;
  (void)hipMemsetAsync((char*)d_ws + S_CTL, 0, (size_t)CTL_WORDS * 4, stream);
  Params p{};
  for (int i = 0; i < 22; ++i) p.in[i] = (const float*)d_in[i];
  p.out = (float*)d_out; p.ws = (unsigned char*)d_ws; p.rep_ph = REP_PH;
  for (int i = 0; i < 32; ++i) p.inv_freq[i] = (float)std::pow(10000.0, -(double)(2 * i) / 64.0);
#if MK_SINGLE
  p.ph_lo = 0; p.ph_hi = NPH;
  void* args[] = {&p};
  hipError_t e = hipLaunchCooperativeKernel((const void*)mega, dim3(grid), dim3(512), args, LDS_BYTES, stream);
  if (e != hipSuccess) fprintf(stderr, "kernel_launch: cooperative launch failed: %s (grid %d)\n", hipGetErrorString(e), grid);
#else
  for (int ph = 0; ph < NPH; ++ph) {
    p.ph_lo = ph; p.ph_hi = ph + 1;
    hipLaunchKernelGGL(mega, dim3(grid), dim3(512), LDS_BYTES, stream, p);
  }
#endif
}
```

```cpp
#include <hip/hip_runtime.h>
#include <cstdio>
#include <cstdint>
#include <cmath>

#ifndef REP_PH
#define REP_PH -1
#endif
#ifndef MK_SINGLE
#define MK_SINGLE 1
#endif

#define LAS __attribute__((address_space(3)))
typedef unsigned short bf16_t;
typedef short bf16x8 __attribute__((ext_vector_type(8)));
typedef short s16x4 __attribute__((ext_vector_type(4)));
typedef float f32x4 __attribute__((ext_vector_type(4)));
typedef float f32x2 __attribute__((ext_vector_type(2)));
typedef float f32x16 __attribute__((ext_vector_type(16)));
typedef unsigned u32x4 __attribute__((ext_vector_type(4)));
typedef unsigned u32x2 __attribute__((ext_vector_type(2)));

constexpr int NTOK = 16384, DM = 2048, SEQ = 8192, NBATCH = 2;
constexpr float EPS = 1e-6f;
constexpr float LOG2E = 1.4426950408889634f;
constexpr int NPH = 19;

constexpr size_t MiB = 1024ull * 1024ull;
constexpr size_t W0_IN = 0;
constexpr size_t W0_QB = W0_IN + 4096ull * 2048 * 2;
constexpr size_t W0_KVB = W0_QB + 1536ull * 512 * 2;
constexpr size_t W0_O = W0_KVB + 2048ull * 256 * 2;
constexpr size_t W1_QKV = 0;
constexpr size_t W1_O = W1_QKV + 6144ull * 2048 * 2;
constexpr size_t W_GU = 32 * MiB;
constexpr size_t W_DN = 96 * MiB;
constexpr size_t ACT = 128 * MiB;
constexpr size_t PROJ = 192 * MiB;
constexpr size_t P_QA = PROJ, P_KA = PROJ + 32 * MiB, P_VA = PROJ + 64 * MiB;
constexpr size_t P_QLAT = PROJ + 96 * MiB, P_KVLAT = PROJ + 112 * MiB, P_KPE = PROJ + 120 * MiB;
constexpr size_t P_Q1 = PROJ, P_K1 = PROJ + 64 * MiB, P_V1 = PROJ + 128 * MiB;
constexpr size_t P_ACT2 = PROJ;
constexpr size_t P_YB = PROJ + 48 * MiB;
constexpr size_t PART = 384 * MiB;
constexpr size_t PT_PA = PART;
constexpr size_t PT_QB = PART + 64 * MiB, PT_KB = PART + 112 * MiB, PT_VB = PART + 160 * MiB;
constexpr size_t PT_H = PART;
constexpr size_t PT_PSEL = PART;
constexpr size_t SMALL = 576 * MiB;
constexpr size_t S_LA = SMALL;
constexpr size_t S_LSEL = S_LA + 1 * MiB;
constexpr size_t S_SSQQ = S_LSEL + 3 * MiB;
constexpr size_t S_SSQKV = S_SSQQ + 256 * 1024;
constexpr size_t S_ROPE = S_SSQKV + 128 * 1024;
constexpr size_t S_KPART = S_ROPE + 2 * MiB;
constexpr size_t S_MLIST = S_KPART + 4 * MiB;
constexpr size_t S_ELIST = S_MLIST + 32ull * 126976 * 4;
constexpr size_t S_TOKG = S_ELIST + 1 * MiB;
constexpr size_t S_CTL = S_TOKG + 128 * 1024;
constexpr int CTL_BAR = 0;
constexpr int CTL_ECNT = 4096;
constexpr int CTL_MCNT = CTL_ECNT + 2 * 16 * 64;
constexpr int CTL_MQ = CTL_MCNT + 1024 + 64;
constexpr int CTL_WORDS = CTL_MQ + 2 * 512;
constexpr size_t S_RSTD = S_CTL + (((size_t)CTL_WORDS * 4 + 255) & ~(size_t)255);
constexpr size_t WS_END = S_RSTD + (size_t)NTOK * 4;

constexpr int LDS_MISC = 147456;
constexpr int LDS_BYTES = LDS_MISC + 2048;

struct Params {
  const float* in[22];
  float* out;
  unsigned char* ws;
  float inv_freq[32];
  int ph_lo, ph_hi;
  int rep_ph, pad;
};
typedef const __attribute__((address_space(4))) Params* PP;

__device__ __forceinline__ int TID() { int t = threadIdx.x; asm volatile("" : "+v"(t)); return t; }
__device__ __forceinline__ unsigned cvtpk(float lo, float hi) { unsigned r; asm("v_cvt_pk_bf16_f32 %0, %1, %2" : "=v"(r) : "v"(lo), "v"(hi)); return r; }
__device__ __forceinline__ float bf2f(unsigned v) { return __uint_as_float(v << 16); }
__device__ __forceinline__ float bflo(unsigned w) { return __uint_as_float(w << 16); }
__device__ __forceinline__ float bfhi(unsigned w) { return __uint_as_float(w & 0xffff0000u); }
__device__ __forceinline__ float wave_sum(float v) {
#pragma unroll
  for (int o = 32; o >= 1; o >>= 1) v += __shfl_xor(v, o);
  return v;
}

#define XB_TMO      128
#define XB_XCNT(j)  (256  + 64 * (j))
#define XB_XSUB(j)  (1280 + 64 * (j))
#define XB_XGEN(j)  (2304 + 64 * (j))
#define XB_TOP      3328
#define XB_TOPGEN   3392
#define XCD_BAR_WORDS 3456
#define XB_SPIN_CAP (1u << 22)
__device__ __forceinline__ unsigned xb_ld(unsigned* p)              { return __hip_atomic_load(p, __ATOMIC_RELAXED, __HIP_MEMORY_SCOPE_AGENT); }
__device__ __forceinline__ unsigned xb_add(unsigned* p, unsigned v) { return __hip_atomic_fetch_add(p, v, __ATOMIC_RELAXED, __HIP_MEMORY_SCOPE_AGENT); }
__device__ __forceinline__ unsigned xb_xcc_id() { return (unsigned)__builtin_amdgcn_s_getreg((3 << 11) | 20) & 0xFu; }
#define XB_SPIN(cond, bar) do { unsigned _sp = 0; while (cond) { __builtin_amdgcn_s_sleep(1); \
    if ((++_sp & 255u) == 0u) { if (xb_ld(&(bar)[XB_TMO])) break; if (_sp > XB_SPIN_CAP) { atomicAdd(&(bar)[XB_TMO], 1u); break; } } } } while (0)
struct XcdBarrier { unsigned* bar; unsigned x; volatile LAS unsigned* st; };
__device__ __forceinline__ XcdBarrier xcd_barrier_post(unsigned* bar, volatile LAS unsigned* st) {
  XcdBarrier b; b.bar = bar; b.x = xb_xcc_id(); b.st = st;
  if (TID() == 0) (void)xb_add(&bar[XB_XCNT(b.x)], 1u);
  return b;
}
__device__ __forceinline__ void xcd_barrier_complete(unsigned* bar, unsigned x, unsigned& nloc, unsigned& nx) {
  const unsigned G = gridDim.x * gridDim.y * gridDim.z;
  unsigned sum, cnt, mine, sp = 0u;
  for (;;) {
    sum = 0u; cnt = 0u; mine = 0u;
#pragma unroll
    for (unsigned j = 0; j < 16; ++j) { const unsigned c = xb_ld(&bar[XB_XCNT(j)]); sum += c; cnt += (c > 0u) ? 1u : 0u; mine = (j == x) ? c : mine; }
    if (sum == G) break;
    __builtin_amdgcn_s_sleep(1);
    if ((++sp & 255u) == 0u) { if (xb_ld(&bar[XB_TMO])) break; if (sp > XB_SPIN_CAP) { atomicAdd(&bar[XB_TMO], 1u); break; } }
  }
  nloc = mine > 0u ? mine : 1u; nx = cnt > 0u ? cnt : 1u;
}
__device__ __forceinline__ void xcd_barrier(const XcdBarrier& b) {
  asm volatile("s_waitcnt vmcnt(0)" ::: "memory");
  __syncthreads();
  if (TID() == 0) {
    unsigned* bar = b.bar;
    __builtin_amdgcn_s_waitcnt(0);
    unsigned nloc = b.st[0], nx = b.st[1];
    if (nloc == 0u) { xcd_barrier_complete(bar, b.x, nloc, nx); b.st[0] = nloc; b.st[1] = nx; }
    const unsigned old = xb_add(&bar[XB_XSUB(b.x)], 1u);
    const unsigned gen = old / nloc;
    if (old + 1u == (gen + 1u) * nloc) {
      __builtin_amdgcn_fence(__ATOMIC_RELEASE, "agent");
      asm volatile("s_waitcnt vmcnt(0)" ::: "memory");
      const unsigned og = xb_add(&bar[XB_TOP], 1u);
      const unsigned tg = og / nx;
      if (og + 1u == (tg + 1u) * nx) xb_add(&bar[XB_TOPGEN], 1u);
      else XB_SPIN(xb_ld(&bar[XB_TOPGEN]) == tg, bar);
      __builtin_amdgcn_fence(__ATOMIC_ACQUIRE, "agent");
      xb_add(&bar[XB_XGEN(b.x)], 1u);
      asm volatile("s_waitcnt vmcnt(0)" ::: "memory");
    } else {
      XB_SPIN(xb_ld(&bar[XB_XGEN(b.x)]) == gen, bar);
      __builtin_amdgcn_fence(__ATOMIC_ACQUIRE, "agent");
      asm volatile("s_waitcnt vmcnt(0)" ::: "memory");
    }
  }
  __syncthreads();
}

struct TJob { const float* W; int K, N; bf16_t* Wt; const float* kscale; int mode; int NR; };
__device__ __forceinline__ void tjob_load(const TJob& j, int idx, int lane, f32x4 (&v)[8], float (&sc)[8]) {
  const int nkt = j.K >> 6, kt = idx % nkt, nt = idx / nkt;
  const float* src = j.W + (long)(kt * 64 + (lane >> 3)) * j.N + nt * 32 + (lane & 7) * 4;
#pragma unroll
  for (int i = 0; i < 8; ++i) v[i] = *(const f32x4*)(src + (long)(8 * i) * j.N);
#pragma unroll
  for (int i = 0; i < 8; ++i) sc[i] = j.kscale ? j.kscale[kt * 64 + (lane >> 3) + 8 * i] : 1.f;
}
__device__ __forceinline__ void tjob_store(const TJob& j, int idx, int lane, const f32x4 (&v)[8], const float (&sc)[8], LAS float* scr) {
  const int nkt = j.K >> 6, kt = idx % nkt, nt = idx / nkt;
#pragma unroll
  for (int i = 0; i < 8; ++i) { LAS float* d = scr + ((lane >> 3) + 8 * i) * 33 + (lane & 7) * 4; d[0] = v[i].x * sc[i]; d[1] = v[i].y * sc[i]; d[2] = v[i].z * sc[i]; d[3] = v[i].w * sc[i]; }
  const int kc = lane & 7;
#pragma unroll
  for (int q = 0; q < 4; ++q) {
    const int n = (lane >> 3) + 8 * q;
    const long drow = (j.mode == 0) ? (long)nt * 32 + n : (long)(nt >> 2) * 256 + ((nt & 3) >> 1) * 128 + (nt & 1) * 32 + n + (j.mode == 2 ? 64 : 0);
    const LAS float* sp = scr + (8 * kc) * 33 + n;
    u32x4 o; o.x = cvtpk(sp[0], sp[33]); o.y = cvtpk(sp[2 * 33], sp[3 * 33]); o.z = cvtpk(sp[4 * 33], sp[5 * 33]); o.w = cvtpk(sp[6 * 33], sp[7 * 33]);
    if (j.NR) *(u32x4*)(j.Wt + ((long)(2 * kt + (kc >> 2)) * j.NR + drow) * 32 + 8 * (kc & 3)) = o;
    else *(u32x4*)(j.Wt + drow * (long)j.K + kt * 64 + 8 * kc) = o;
  }
}

__device__ __forceinline__ void load_row(const float* src, int lane, f32x4 (&v)[8]) {
  const f32x4* s4 = (const f32x4*)src + lane;
#pragma unroll
  for (int i = 0; i < 8; ++i) v[i] = s4[64 * i];
}
__device__ __forceinline__ void add_bf16_row(const bf16_t* y, int lane, f32x4 (&v)[8]) {
  const u32x2* y2 = (const u32x2*)y + lane;
#pragma unroll
  for (int i = 0; i < 8; ++i) { const u32x2 w = y2[64 * i]; v[i].x += bflo(w.x); v[i].y += bfhi(w.x); v[i].z += bflo(w.y); v[i].w += bfhi(w.y); }
}
__device__ __forceinline__ void yrow_to_f32(const u32x2 (&w)[8], f32x4 (&v)[8]) {
#pragma unroll
  for (int i = 0; i < 8; ++i) { v[i].x = bflo(w[i].x); v[i].y = bfhi(w[i].x); v[i].z = bflo(w[i].y); v[i].w = bfhi(w[i].y); }
}
__device__ __forceinline__ void load_yrow(const bf16_t* y, int lane, u32x2 (&w)[8]) {
  const u32x2* y2 = (const u32x2*)y + lane;
#pragma unroll
  for (int i = 0; i < 8; ++i) w[i] = y2[64 * i];
}
__device__ __forceinline__ void add_yrow(const u32x2 (&w)[8], f32x4 (&v)[8]) {
#pragma unroll
  for (int i = 0; i < 8; ++i) { v[i].x += bflo(w[i].x); v[i].y += bfhi(w[i].x); v[i].z += bflo(w[i].y); v[i].w += bfhi(w[i].y); }
}
__device__ __forceinline__ void store_row_f32(float* dst, int lane, const f32x4 (&v)[8]) {
  f32x4* d4 = (f32x4*)dst + lane;
#pragma unroll
  for (int i = 0; i < 8; ++i) d4[64 * i] = v[i];
}
__device__ __forceinline__ float norm_row(f32x4 (&v)[8], const float* g, int lane) {
  float s = 0.f;
#pragma unroll
  for (int i = 0; i < 8; ++i) s += (v[i].x * v[i].x + v[i].y * v[i].y) + (v[i].z * v[i].z + v[i].w * v[i].w);
  s = wave_sum(s);
  const float r = rsqrtf(s * (1.f / DM) + EPS);
  const f32x4* g4 = (const f32x4*)g + lane;
#pragma unroll
  for (int i = 0; i < 8; ++i) { const f32x4 gg = g4[64 * i]; v[i] = v[i] * r * gg; }
  return r;
}
__device__ __forceinline__ void store_row_bf16(bf16_t* dst, int lane, const f32x4 (&v)[8]) {
  u32x2* d2 = (u32x2*)dst + lane;
#pragma unroll
  for (int i = 0; i < 8; ++i) { u32x2 w; w.x = cvtpk(v[i].x, v[i].y); w.y = cvtpk(v[i].z, v[i].w); d2[64 * i] = w; }
}

#define GLDS16(g, l) __builtin_amdgcn_global_load_lds((const unsigned*)(g), (LAS unsigned*)(l), 16, 0, 0)
template <int NT> struct Gemm {
  static constexpr int STG = 32768 + NT * 2048;
  static constexpr int NBI = NT / 4;
  static constexpr int NS = (3 * STG <= LDS_MISC) ? 3 : 2;
  template <class ARow, int PV = 0>
  static __device__ __forceinline__ void run(LAS unsigned char* lds, ARow arow, const char* Bt0, long ldb, int K, f32x4 (&acc)[2][NT]) {
    const int tid = TID(), lane = tid & 63, w = __builtin_amdgcn_readfirstlane(tid >> 6);
    const int fr = lane & 15, fq = lane >> 4;
    const int srow = lane >> 3, schunk = (lane & 7) ^ srow;
    const char* ap[4]; const char* bp[NBI];
#pragma unroll
    for (int i = 0; i < 4; ++i) ap[i] = arow((4 * w + i) * 8 + srow) + schunk * 16;
#pragma unroll
    for (int i = 0; i < NBI; ++i) bp[i] = Bt0 + (long)((w * NBI + i) * 8 + srow) * ldb + schunk * 16;
#pragma unroll
    for (int m = 0; m < 2; ++m)
#pragma unroll
      for (int n = 0; n < NT; ++n) acc[m][n] = (f32x4){0.f, 0.f, 0.f, 0.f};
    const int x0 = ((fq) ^ (fr & 7)) << 4, x1 = ((4 + fq) ^ (fr & 7)) << 4;
    const int abase = (32 * w + fr) * 128, bbase = 32768 + fr * 128;
    const int nk = K >> 6;
#define GEMM_STAGE(s, k0) do { \
      _Pragma("unroll") for (int i = 0; i < 4; ++i) GLDS16(ap[i] + (k0) * 2, lds + (s) * STG + (4 * w + i) * 1024); \
      _Pragma("unroll") for (int i = 0; i < NBI; ++i) GLDS16(bp[i] + (k0) * 2, lds + (s) * STG + 32768 + (w * NBI + i) * 1024); } while (0)
#define GEMM_WAIT_1() do { if (NBI == 2) asm volatile("s_waitcnt vmcnt(6)" ::: "memory"); else if (NBI == 3) asm volatile("s_waitcnt vmcnt(7)" ::: "memory"); else asm volatile("s_waitcnt vmcnt(8)" ::: "memory"); } while (0)
    GEMM_STAGE(0, 0);
    if (NS == 3 && nk > 1) GEMM_STAGE(1, 64);
    int s = 0;
    for (int kt = 0; kt < nk; ++kt) {
      if (NS == 3 && kt + 1 < nk) GEMM_WAIT_1(); else asm volatile("s_waitcnt vmcnt(0)" ::: "memory");
      __builtin_amdgcn_s_barrier();
      asm volatile("" ::: "memory");
      const bool do_stage = (kt + NS - 1 < nk) && PV != 1;
      const int sn = (s + NS - 1 >= NS) ? s - 1 : s + NS - 1; const int kn = (kt + NS - 1) * 64;
      const LAS unsigned char* sb = lds + s * STG;
      constexpr int G = NT / 4;
      bf16x8 af[2][2], bfr[2][4];
#define LDA_(kk_) do { af[kk_][0] = *(const LAS bf16x8*)(sb + abase + ((kk_) ? x1 : x0)); af[kk_][1] = *(const LAS bf16x8*)(sb + abase + 2048 + ((kk_) ? x1 : x0)); } while (0)
#define LDB_(buf_, kk_, g_) do { _Pragma("unroll") for (int j = 0; j < 4; ++j) bfr[buf_][j] = *(const LAS bf16x8*)(sb + bbase + (4 * (g_) + j) * 2048 + ((kk_) ? x1 : x0)); } while (0)
      if (PV != 2) { LDA_(0); LDB_(0, 0, 0); }
#pragma unroll
      for (int gi = 0; gi < (PV == 2 ? 0 : 2 * G); ++gi) {
        const int kk = gi / G, g = gi % G;
        if (gi + 1 < 2 * G) { const int kk2 = (gi + 1) / G, g2 = (gi + 1) % G; LDB_((gi + 1) & 1, kk2, g2); if (g2 == 0) LDA_(1); }
        if (do_stage) {
          constexpr int NGL = 4 + NBI, PER = (NGL + 2 * G - 1) / (2 * G);
#pragma unroll
          for (int q = gi * PER; q < (gi + 1) * PER && q < NGL; ++q) {
            if (q < 4) GLDS16(ap[q] + kn * 2, lds + sn * STG + (4 * w + q) * 1024);
            else GLDS16(bp[q - 4] + kn * 2, lds + sn * STG + 32768 + (w * NBI + (q - 4)) * 1024);
          }
        }
        __builtin_amdgcn_sched_barrier(0);
        __builtin_amdgcn_s_setprio(1);
#pragma unroll
        for (int j = 0; j < 4; ++j) {
          acc[0][4 * g + j] = __builtin_amdgcn_mfma_f32_16x16x32_bf16(bfr[gi & 1][j], af[kk][0], acc[0][4 * g + j], 0, 0, 0);
          acc[1][4 * g + j] = __builtin_amdgcn_mfma_f32_16x16x32_bf16(bfr[gi & 1][j], af[kk][1], acc[1][4 * g + j], 0, 0, 0);
        }
        __builtin_amdgcn_s_setprio(0);
        __builtin_amdgcn_sched_barrier(0);
      }
#undef LDA_
#undef LDB_
      s = (s + 1 == NS) ? 0 : s + 1;
    }
    asm volatile("s_waitcnt lgkmcnt(0)" ::: "memory");
    __builtin_amdgcn_s_barrier();
    asm volatile("" ::: "memory");
#undef GEMM_STAGE
#undef GEMM_WAIT_1
  }
};

struct GemmS {
  const char* ap[2]; const char* bp[2];
  long aks, bks;
  template <class ARow>
  __device__ __forceinline__ void prep(LAS unsigned char* lds, ARow arow, const char* Bt0, long bks_) {
    const int tid = TID(), lane = tid & 63, w = __builtin_amdgcn_readfirstlane(tid >> 6);
    const int prow = lane >> 2, pch = (lane & 3) ^ ((-(prow >> 2)) & 3);
    aks = 64; bks = bks_;
#pragma unroll
    for (int i = 0; i < 2; ++i) { ap[i] = arow(16 * (2 * w + i) + prow) + pch * 16; bp[i] = Bt0 + (long)(16 * (2 * w + i) + prow) * 64 + pch * 16; }
#pragma unroll
    for (int s_ = 0; s_ < 3; ++s_) issue(lds, w, s_);
  }
  __device__ __forceinline__ void issue(LAS unsigned char* lds, int w, int s_) {
    const int sl_ = (s_ & 3) * 32768; const long ka_ = (long)s_ * aks, kb_ = (long)s_ * bks;
    GLDS16(ap[0] + ka_, lds + sl_ + (2 * w) * 1024); GLDS16(ap[1] + ka_, lds + sl_ + (2 * w + 1) * 1024);
    GLDS16(bp[0] + kb_, lds + sl_ + 16384 + (2 * w) * 1024); GLDS16(bp[1] + kb_, lds + sl_ + 16384 + (2 * w + 1) * 1024);
  }
  __device__ __forceinline__ void main(LAS unsigned char* lds, int K, f32x4 (&acc)[4][8]) {
    const int tid = TID(), lane = tid & 63, w = __builtin_amdgcn_readfirstlane(tid >> 6), half = w >> 2, wm = w & 3;
    const int fr = lane & 15, fq = lane >> 4;
#pragma unroll
    for (int m = 0; m < 4; ++m)
#pragma unroll
      for (int n = 0; n < 8; ++n) acc[m][n] = (f32x4){0.f, 0.f, 0.f, 0.f};
    const int rbase = fr * 64 + ((fq ^ ((-(fr >> 2)) & 3)) << 4);
    const int S = K >> 5;
#define GS_BAR() do { __builtin_amdgcn_s_barrier(); asm volatile("" ::: "memory"); } while (0)
    asm volatile("s_waitcnt vmcnt(4)" ::: "memory");
    GS_BAR();
    if (half == 1) GS_BAR();
#pragma unroll 1
    for (int s = 0; s < S; ++s) {
      const LAS unsigned char* sb = lds + (s & 3) * 32768 + rbase;
      bf16x8 af[4], bfr[8];
#pragma unroll
      for (int m = 0; m < 4; ++m) af[m] = *(const LAS bf16x8*)(sb + (64 * wm + 16 * m) * 64);
#pragma unroll
      for (int n = 0; n < 8; ++n) bfr[n] = *(const LAS bf16x8*)(sb + 16384 + (128 * half + 16 * n) * 64);
      if (s + 3 < S) issue(lds, w, s + 3);
      const int c = (s + 3 < S ? 1 : 0) + (s + 2 < S ? 1 : 0);
      if (c == 2) asm volatile("s_waitcnt vmcnt(8)" ::: "memory"); else if (c == 1) asm volatile("s_waitcnt vmcnt(4)" ::: "memory"); else asm volatile("s_waitcnt vmcnt(0)" ::: "memory");
      asm volatile("s_waitcnt lgkmcnt(0)" ::: "memory");
      GS_BAR();
      __builtin_amdgcn_sched_barrier(0);
      __builtin_amdgcn_s_setprio(1);
#pragma unroll
      for (int n = 0; n < 8; ++n)
#pragma unroll
        for (int m = 0; m < 4; ++m) acc[m][n] = __builtin_amdgcn_mfma_f32_16x16x32_bf16(bfr[n], af[m], acc[m][n], 0, 0, 0);
      __builtin_amdgcn_s_setprio(0);
      __builtin_amdgcn_sched_barrier(0);
      GS_BAR();
    }
    if (half == 0) GS_BAR();
#undef GS_BAR
  }
};
template <class PrepFn, class EpiFn>
__device__ __forceinline__ void gemms_phase(LAS unsigned char* lds, int ntiles, int K, PrepFn prep_tile, EpiFn epi) {
  GemmS g;
  int t = blockIdx.x;
  if (t < ntiles) prep_tile(t, g);
  while (t < ntiles) {
    const int tn = t + gridDim.x;
    f32x4 acc[4][8];
    g.main(lds, K, acc);
    if (tn < ntiles) prep_tile(tn, g);
    epi(t, acc);
    t = tn;
  }
}
__device__ __forceinline__ void tile_map(int t, int nRT, int nNT, int& rt, int& nt) {
  const int per = 16 * nNT, g = t / per, r = t - g * per, rem = nRT - 16 * g, gsz = rem < 16 ? rem : 16;
  rt = 16 * g + r % gsz; nt = r / gsz;
}
template <int NT> __device__ __forceinline__ float rowssq(const f32x4 (&a)[NT]) {
  float s = 0.f;
#pragma unroll
  for (int n = 0; n < NT; ++n) s += (a[n].x * a[n].x + a[n].y * a[n].y) + (a[n].z * a[n].z + a[n].w * a[n].w);
  s += __shfl_xor(s, 16); s += __shfl_xor(s, 32);
  return s;
}
__device__ __forceinline__ void store4(bf16_t* p, f32x4 v) { u32x2 w; w.x = cvtpk(v.x, v.y); w.y = cvtpk(v.z, v.w); *(u32x2*)p = w; }

__device__ __forceinline__ void phase_inproj(PP p, LAS unsigned char* lds) {
  unsigned char* ws = p->ws;
  const bf16_t* A = (const bf16_t*)(ws + ACT); const char* Bt = (const char*)(ws + W0_IN);
  const int lane = TID() & 63, w = __builtin_amdgcn_readfirstlane(TID() >> 6); int fr = lane & 15, fq = lane >> 4;
  gemms_phase(lds, 64 * 16, 2048,
    [&](int t, GemmS& g) { int rt, nt2; tile_map(t, 64, 16, rt, nt2); g.prep(lds, [&](int r) { return (const char*)(A + (long)(rt * 256 + r) * 2048); }, Bt + (long)nt2 * 256 * 64, 4096l * 64); },
    [&](int t, f32x4 (&acc)[4][8]) {
    int rt, nt2; tile_map(t, 64, 16, rt, nt2);
    asm volatile("" : "+v"(fr), "+v"(fq));
    {
      const int nt = nt2 * 2 + (w >> 2);
#pragma unroll
      for (int m = 0; m < 4; ++m) {
        f32x4 a[8];
#pragma unroll
        for (int n = 0; n < 8; ++n) a[n] = acc[m][n];
        const long tok = rt * 256 + 64 * (w & 3) + 16 * m + fr;
        if (nt < 24) {
          const int which = nt >> 3, h = nt & 7;
          bf16_t* dst = (bf16_t*)(ws + (which == 0 ? P_QA : which == 1 ? P_KA : P_VA)) + tok * 1024 + h * 128 + 4 * fq;
          if (which < 2) {
            const float r = rsqrtf(rowssq<8>(a) * (1.f / 128.f) + EPS);
            const float* g = p->in[which == 0 ? 7 : 8] + 4 * fq;
#pragma unroll
            for (int n = 0; n < 8; ++n) store4(dst + 16 * n, a[n] * r * *(const f32x4*)(g + 16 * n));
          } else {
#pragma unroll
            for (int n = 0; n < 8; ++n) store4(dst + 16 * n, a[n]);
          }
        } else if (nt < 28) {
          const int c = nt - 24;
          bf16_t* dst = (bf16_t*)(ws + P_QLAT) + tok * 512 + c * 128 + 4 * fq;
          const float sq = rowssq<8>(a);
          if (fq == 0) ((float*)(ws + S_SSQQ))[tok * 4 + c] = sq;
#pragma unroll
          for (int n = 0; n < 8; ++n) store4(dst + 16 * n, a[n]);
        } else if (nt < 30) {
          const int c = nt - 28;
          bf16_t* dst = (bf16_t*)(ws + P_KVLAT) + tok * 256 + c * 128 + 4 * fq;
          const float sq = rowssq<8>(a);
          if (fq == 0) ((float*)(ws + S_SSQKV))[tok * 2 + c] = sq;
#pragma unroll
          for (int n = 0; n < 8; ++n) store4(dst + 16 * n, a[n]);
        } else if (nt == 30) {
          bf16_t* dst = (bf16_t*)(ws + P_KPE) + tok * 64 + 4 * fq;
#pragma unroll
          for (int n = 0; n < 4; ++n) store4(dst + 16 * n, a[n]);
        }
      }
    }
  });
}

__device__ __forceinline__ void phase_qkvb(PP p, LAS unsigned char* lds) {
  unsigned char* ws = p->ws;
  const int lane = TID() & 63, w = __builtin_amdgcn_readfirstlane(TID() >> 6); int fr = lane & 15, fq = lane >> 4;
  const float* rope = (const float*)(ws + S_ROPE);
  {
    const bf16_t* A = (const bf16_t*)(ws + P_QLAT); const char* Bt = (const char*)(ws + W0_QB);
    const float* ssq = (const float*)(ws + S_SSQQ); const float* g = p->in[9] + 4 * fq;
    bf16_t* QB = (bf16_t*)(ws + PT_QB);
    for (int t = blockIdx.x; t < 64 * 8; t += gridDim.x) {
      int rt, h; tile_map(t, 64, 8, rt, h);
      f32x4 acc[2][12];
      Gemm<12>::run(lds, [&](int r) { return (const char*)(A + (long)(rt * 256 + r) * 512); }, Bt + (long)h * 192 * 1024, 1024, 512, acc);
    asm volatile("" : "+v"(fr), "+v"(fq));
#pragma unroll
      for (int m = 0; m < 2; ++m) {
        const long tok = rt * 256 + 32 * w + 16 * m + fr;
        const f32x4 sq = *(const f32x4*)(ssq + tok * 4);
        const float rstd = rsqrtf(((sq.x + sq.y) + (sq.z + sq.w)) * (1.f / 512.f) + EPS);
#pragma unroll
        for (int n = 0; n < 12; ++n) acc[m][n] = acc[m][n] * rstd;
        const float r2 = rsqrtf(rowssq<12>(acc[m]) * (1.f / 192.f) + EPS);
#pragma unroll
        for (int n = 0; n < 12; ++n) acc[m][n] = acc[m][n] * r2 * *(const f32x4*)(g + 16 * n);
        const int pos = (int)(tok & (SEQ - 1));
#pragma unroll
        for (int a = 0; a < 2; ++a) {
          const f32x4 cs0 = *(const f32x4*)(rope + ((long)pos * 32 + 16 * a + 4 * fq) * 2), cs1 = *(const f32x4*)(rope + ((long)pos * 32 + 16 * a + 4 * fq) * 2 + 4);
          const f32x4 c = {cs0.x, cs0.z, cs1.x, cs1.z}, s = {cs0.y, cs0.w, cs1.y, cs1.w};
          const f32x4 x1 = acc[m][8 + a], x2 = acc[m][10 + a];
          acc[m][8 + a] = x1 * c - x2 * s; acc[m][10 + a] = x1 * s + x2 * c;
        }
        bf16_t* dst = QB + tok * 1536 + h * 192 + 4 * fq;
#pragma unroll
        for (int n = 0; n < 12; ++n) store4(dst + 16 * n, acc[m][n]);
      }
    }
  }
  {
    const bf16_t* A = (const bf16_t*)(ws + P_KVLAT); const char* Bt = (const char*)(ws + W0_KVB);
    const float* ssq = (const float*)(ws + S_SSQKV); const float* g = p->in[10];
    const bf16_t* KPE = (const bf16_t*)(ws + P_KPE);
    bf16_t* KB = (bf16_t*)(ws + PT_KB); bf16_t* VB = (bf16_t*)(ws + PT_VB);
    gemms_phase(lds, 64 * 8, 256,
      [&](int t, GemmS& g) { int rt, h; tile_map(t, 64, 8, rt, h); g.prep(lds, [&](int r) { return (const char*)(A + (long)(rt * 256 + r) * 256); }, Bt + (long)h * 256 * 64, 2048l * 64); },
      [&](int t, f32x4 (&acc)[4][8]) {
      int rt, h; tile_map(t, 64, 8, rt, h);
    asm volatile("" : "+v"(fr), "+v"(fq));
#pragma unroll
      for (int m = 0; m < 4; ++m) {
        const long tok = rt * 256 + 64 * (w & 3) + 16 * m + fr;
        const float rstd = rsqrtf((ssq[tok * 2] + ssq[tok * 2 + 1]) * (1.f / 256.f) + EPS);
        f32x4 kn[8];
#pragma unroll
        for (int n = 0; n < 8; ++n) kn[n] = acc[m][n] * rstd;
        if (w >> 2) {
          bf16_t* dst = VB + tok * 1024 + h * 128 + 4 * fq;
#pragma unroll
          for (int n = 0; n < 8; ++n) store4(dst + 16 * n, kn[n]);
        } else {
          const u32x4 pa = *(const u32x4*)(KPE + tok * 64 + 8 * fq), pb = *(const u32x4*)(KPE + tok * 64 + 32 + 8 * fq);
          float e1[8] = {bflo(pa.x), bfhi(pa.x), bflo(pa.y), bfhi(pa.y), bflo(pa.z), bfhi(pa.z), bflo(pa.w), bfhi(pa.w)};
          float e2[8] = {bflo(pb.x), bfhi(pb.x), bflo(pb.y), bfhi(pb.y), bflo(pb.z), bfhi(pb.z), bflo(pb.w), bfhi(pb.w)};
          float spe = 0.f;
#pragma unroll
          for (int e = 0; e < 8; ++e) spe += e1[e] * e1[e] + e2[e] * e2[e];
          spe += __shfl_xor(spe, 16); spe += __shfl_xor(spe, 32);
          const float rk = rsqrtf((rowssq<8>(kn) + spe) * (1.f / 192.f) + EPS);
          bf16_t* dst = KB + tok * 1536 + h * 192;
#pragma unroll
          for (int n = 0; n < 8; ++n) store4(dst + 16 * n + 4 * fq, kn[n] * rk * *(const f32x4*)(g + 16 * n + 4 * fq));
          const int pos = (int)(tok & (SEQ - 1));
          const float* cs = rope + ((long)pos * 32 + 8 * fq) * 2;
          float o1[8], o2[8];
#pragma unroll
          for (int e = 0; e < 8; ++e) {
            const float x = e1[e] * rk * g[128 + 8 * fq + e], y = e2[e] * rk * g[160 + 8 * fq + e], c = cs[2 * e], sn = cs[2 * e + 1];
            o1[e] = x * c - y * sn; o2[e] = x * sn + y * c;
          }
          u32x4 w1 = {cvtpk(o1[0], o1[1]), cvtpk(o1[2], o1[3]), cvtpk(o1[4], o1[5]), cvtpk(o1[6], o1[7])};
          u32x4 w2 = {cvtpk(o2[0], o2[1]), cvtpk(o2[2], o2[3]), cvtpk(o2[4], o2[5]), cvtpk(o2[6], o2[7])};
          *(u32x4*)(dst + 128 + 8 * fq) = w1; *(u32x4*)(dst + 160 + 8 * fq) = w2;
        }
      }
    });
  }
}

template <bool RB16> __device__ __forceinline__ void phase_outproj(PP p, LAS unsigned char* lds, const char* Bt, const void* __restrict__ resid_, bf16_t* __restrict__ dst) {
  const float* resid = (const float*)resid_; const bf16_t* resid16 = (const bf16_t*)resid_;
  unsigned char* ws = p->ws;
  const bf16_t* A = (const bf16_t*)(ws + ACT);
  const int lane = TID() & 63, w = __builtin_amdgcn_readfirstlane(TID() >> 6); int fr = lane & 15, fq = lane >> 4;
  gemms_phase(lds, 64 * 8, 2048,
    [&](int t, GemmS& g) { int rt, nt; tile_map(t, 64, 8, rt, nt); g.prep(lds, [&](int r) { return (const char*)(A + (long)(rt * 256 + r) * 2048); }, Bt + (long)nt * 256 * 64, 2048l * 64); },
    [&](int t, f32x4 (&acc)[4][8]) {
    int rt, nt; tile_map(t, 64, 8, rt, nt);
    asm volatile("" : "+v"(fr), "+v"(fq));
#pragma unroll
    for (int m = 0; m < 4; ++m) {
      const long off = (long)(rt * 256 + 64 * (w & 3) + 16 * m + fr) * 2048 + nt * 256 + 128 * (w >> 2) + 4 * fq;
      f32x4 rv[8];
      if constexpr (RB16) {
        u32x2 rw[8];
#pragma unroll
        for (int n = 0; n < 8; ++n) rw[n] = *(const u32x2*)(resid16 + off + 16 * n);
#pragma unroll
        for (int n = 0; n < 8; ++n) { rv[n].x = bflo(rw[n].x); rv[n].y = bfhi(rw[n].x); rv[n].z = bflo(rw[n].y); rv[n].w = bfhi(rw[n].y); }
      } else {
#pragma unroll
        for (int n = 0; n < 8; ++n) rv[n] = *(const f32x4*)(resid + off + 16 * n);
      }
#pragma unroll
      for (int n = 0; n < 8; ++n) store4(dst + off + 16 * n, rv[n] + acc[m][n]);
    }
  });
}

__device__ __forceinline__ void phase_qkv1(PP p, LAS unsigned char* lds) {
  unsigned char* ws = p->ws;
  const bf16_t* A = (const bf16_t*)p->out; const char* Bt = (const char*)(ws + W1_QKV);
  const float* rstd = (const float*)(ws + S_RSTD);
  const int lane = TID() & 63, w = __builtin_amdgcn_readfirstlane(TID() >> 6); int fr = lane & 15, fq = lane >> 4;
  float* kpart = (float*)(ws + S_KPART);
  gemms_phase(lds, 64 * 24, 2048,
    [&](int t, GemmS& g) { int rt, nt2; tile_map(t, 64, 24, rt, nt2); g.prep(lds, [&](int r) { return (const char*)(A + (long)(rt * 256 + r) * 2048); }, Bt + (long)nt2 * 256 * 64, 6144l * 64); },
    [&](int t, f32x4 (&acc)[4][8]) {
    int rt, nt2; tile_map(t, 64, 24, rt, nt2);
    asm volatile("" : "+v"(fr), "+v"(fq));
    const int which = nt2 >> 3;
    bf16_t* base = (bf16_t*)(ws + (which == 0 ? P_Q1 : which == 1 ? P_K1 : P_V1));
    const int h = (nt2 * 2 + (w >> 2)) & 15, wm = w & 3;
#pragma unroll
    for (int m = 0; m < 4; ++m) {
      const float rs = rstd[rt * 256 + 64 * wm + 16 * m + fr];
#pragma unroll
      for (int n = 0; n < 8; ++n) acc[m][n] = acc[m][n] * rs;
    }
    if (which < 2) {
      const float* g = p->in[which == 0 ? 13 : 14] + 4 * fq;
#pragma unroll
      for (int m = 0; m < 4; ++m) {
        const float r = rsqrtf(rowssq<8>(acc[m]) * (1.f / 128.f) + EPS);
#pragma unroll
        for (int n = 0; n < 8; ++n) acc[m][n] = acc[m][n] * r * *(const f32x4*)(g + 16 * n);
      }
      if (which == 1) {
#pragma unroll
        for (int c2 = 0; c2 < 2; ++c2) {
          float* kp = kpart + ((long)(rt * 8 + wm * 2 + c2) * 16 + h) * 128 + 4 * fq;
#pragma unroll
          for (int n = 0; n < 8; ++n) {
            f32x4 sm = acc[2 * c2][n] + acc[2 * c2 + 1][n];
#pragma unroll
            for (int o = 1; o < 16; o <<= 1) { sm.x += __shfl_xor(sm.x, o); sm.y += __shfl_xor(sm.y, o); sm.z += __shfl_xor(sm.z, o); sm.w += __shfl_xor(sm.w, o); }
            if (fr == 0) *(f32x4*)(kp + 16 * n) = sm;
          }
        }
      }
    }
#pragma unroll
    for (int m = 0; m < 4; ++m) {
      bf16_t* dst = base + (long)(rt * 256 + 64 * wm + 16 * m + fr) * 2048 + h * 128 + 4 * fq;
#pragma unroll
      for (int n = 0; n < 8; ++n) store4(dst + 16 * n, acc[m][n]);
    }
  });
}

__device__ __forceinline__ TJob moe_tjob(PP p, int layer, int idx, int& sub) {
  unsigned char* ws = p->ws;
  const int kind = idx >> 13, r = idx & 8191, e = r >> 9; sub = r & 511;
  TJob j;
  if (kind < 2) { j.W = p->in[kind == 0 ? 19 : 20] + ((long)layer * 16 + e) * 2048 * 512; j.K = 2048; j.N = 512; j.Wt = (bf16_t*)(ws + W_GU) + (long)e * 1024 * 2048; j.kscale = p->in[16] + layer * 2048; j.mode = 1 + kind; j.NR = 1024; }
  else { j.W = p->in[21] + ((long)layer * 16 + e) * 512 * 2048; j.K = 512; j.N = 2048; j.Wt = (bf16_t*)(ws + W_DN) + (long)e * 2048 * 512; j.kscale = nullptr; j.mode = 0; j.NR = 2048; }
  return j;
}
__device__ __forceinline__ TJob tjob0(PP p, int it, int& sub) {
  unsigned char* ws = p->ws;
  constexpr int J_IN = 32 * 122, J_QB = 8 * 48, J_KVB = 4 * 64, J_O = 32 * 64;
  int r = it;
  if (r < J_IN) { sub = r; return TJob{p->in[2], 2048, 3904, (bf16_t*)(ws + W0_IN), nullptr, 0, 4096}; } r -= J_IN;
  if (r < J_QB) { sub = r; return TJob{p->in[4], 512, 1536, (bf16_t*)(ws + W0_QB), p->in[3], 0, 0}; } r -= J_QB;
  if (r < J_KVB) { sub = r; return TJob{p->in[6], 256, 2048, (bf16_t*)(ws + W0_KVB), p->in[5], 0, 2048}; } r -= J_KVB;
  if (r < J_O) { sub = r; return TJob{p->in[11], 2048, 2048, (bf16_t*)(ws + W0_O), nullptr, 0, 2048}; } r -= J_O;
  return moe_tjob(p, 0, r, sub);
}
__device__ __forceinline__ TJob tjob1(PP p, int it, int& sub) {
  unsigned char* ws = p->ws;
  constexpr int J_QKV = 32 * 192, J_O = 32 * 64;
  int r = it;
  if (r < J_QKV) { sub = r; return TJob{p->in[12], 2048, 6144, (bf16_t*)(ws + W1_QKV), p->in[1] + 2048, 0, 6144}; } r -= J_QKV;
  if (r < J_O) { sub = r; return TJob{p->in[15], 2048, 2048, (bf16_t*)(ws + W1_O), nullptr, 0, 2048}; } r -= J_O;
  return moe_tjob(p, 1, r, sub);
}
template <int LAYER> __device__ __forceinline__ void run_tjobs_core(PP p, LAS unsigned char* lds, int it0, int stride, int jhi) {
  const int lane = TID() & 63, wave = TID() >> 6;
  LAS float* scr = (LAS float*)lds + wave * (64 * 33);
  int it = it0 + wave;
  f32x4 va[8], vb[8], vc[8]; float sa[8], sb[8], sc[8];
  if (it < jhi) { int sub; const TJob j = LAYER == 0 ? tjob0(p, it, sub) : tjob1(p, it, sub); tjob_load(j, sub, lane, va, sa); }
  if (it + stride < jhi) { int sub; const TJob j = LAYER == 0 ? tjob0(p, it + stride, sub) : tjob1(p, it + stride, sub); tjob_load(j, sub, lane, vb, sb); }
  while (it < jhi) {
    const int nx = it + stride, nx2 = nx + stride;
    if (nx2 < jhi) { int sub; const TJob j = LAYER == 0 ? tjob0(p, nx2, sub) : tjob1(p, nx2, sub); tjob_load(j, sub, lane, vc, sc); }
    { int sub; const TJob j = LAYER == 0 ? tjob0(p, it, sub) : tjob1(p, it, sub); tjob_store(j, sub, lane, va, sa, scr); }
#pragma unroll
    for (int i = 0; i < 8; ++i) { va[i] = vb[i]; vb[i] = vc[i]; sa[i] = sb[i]; sb[i] = sc[i]; }
    it = nx;
  }
}
template <int LAYER> __device__ __forceinline__ void run_tjobs(PP p, LAS unsigned char* lds, int jlo, int jhi, int first) {
  if ((int)blockIdx.x < first) return;
  run_tjobs_core<LAYER>(p, lds, jlo + (blockIdx.x - first) * 8, (gridDim.x - first) * 8, jhi);
}
template <int LAYER> __device__ __forceinline__ void run_tjobs_blk(PP p, LAS unsigned char* lds, int jlo, int jhi) {
  run_tjobs_core<LAYER>(p, lds, jlo, 8, jhi);
}
constexpr int TJ0_DENSE = 32 * 122 + 8 * 48 + 4 * 64 + 32 * 64, TJ0_TOTAL = TJ0_DENSE + 24576;
constexpr int TJ1_DENSE = 32 * 192 + 32 * 64, TJ1_GU = 16384, TJ1_TOTAL = TJ1_DENSE + 24576;
__device__ __forceinline__ void moe_setup(PP p, int layer, LAS int* mi) {
  if (TID() == 0) {
    const unsigned* cnt = (const unsigned*)(p->ws + S_CTL) + CTL_ECNT + layer * 16 * 64;
    int acc = 0;
    for (int e = 0; e < 16; ++e) { const int c = (int)cnt[e * 64]; mi[e] = acc; mi[17 + e] = c; acc += (c + 255) >> 8; }
    mi[16] = acc;
  }
  __syncthreads();
}
__device__ __forceinline__ int moe_expert_of(const LAS int* mi, int R) {
  int e = 0;
#pragma unroll
  for (int k = 1; k < 16; ++k) if (R >= mi[k]) e = k;
  return e;
}
constexpr int TJ_CHUNK = 64;
__device__ __forceinline__ void phase_moe(PP p, LAS unsigned char* lds, int layer) {
  unsigned char* ws = p->ws;
  LAS int* mi = (LAS int*)(lds + LDS_MISC + 64);
  moe_setup(p, layer, mi);
  const int totRT = mi[16], n7 = totRT * 4, n8 = totRT * 8;
  const bf16_t* A = (const bf16_t*)(ws + PT_H);
  const float* rstd = (const float*)(ws + S_RSTD);
  const unsigned* elist = (const unsigned*)(ws + S_ELIST);
  bf16_t* act2 = (bf16_t*)(ws + P_ACT2);
  const float* tokg = (const float*)(ws + S_TOKG);
  bf16_t* yb = (bf16_t*)(ws + P_YB);
  unsigned* mq = (unsigned*)(ws + S_CTL) + CTL_MQ + layer * 512;
  unsigned* barw = (unsigned*)(ws + S_CTL) + CTL_BAR;
  const int lane = TID() & 63, w = __builtin_amdgcn_readfirstlane(TID() >> 6); int fr = lane & 15, fq = lane >> 4;
  gemms_phase(lds, n7, 2048,
    [&](int t, GemmS& g) { int R, j4; tile_map(t, totRT, 4, R, j4);
      const int e = moe_expert_of(mi, R), cnt = mi[17 + e], lrow0 = (R - mi[e]) * 256; const unsigned* el = elist + e * 16384;
      g.prep(lds, [&](int r) { int li = lrow0 + r; li = li < cnt ? li : cnt - 1; const unsigned tok = el[li] >> 1; return (const char*)(A + (long)tok * 2048); },
             (const char*)(ws + W_GU) + (long)e * 1024 * 4096 + (long)j4 * 256 * 64, 1024l * 64); },
    [&](int t, f32x4 (&acc)[4][8]) {
    int R, j4; tile_map(t, totRT, 4, R, j4);
    const int e = moe_expert_of(mi, R), cnt = mi[17 + e], lrow0 = (R - mi[e]) * 256;
    asm volatile("" : "+v"(fr), "+v"(fq));
#pragma unroll
    for (int m = 0; m < 4; ++m) {
      const int lr = 64 * (w & 3) + 16 * m + fr;
      if (lrow0 + lr < cnt) {
        bf16_t* dst = act2 + ((long)R * 256 + lr) * 512 + j4 * 128 + 64 * (w >> 2) + 4 * fq;
        const float rs = rstd[elist[e * 16384 + lrow0 + lr] >> 1];
#pragma unroll
        for (int n = 0; n < 4; ++n) {
          const f32x4 g = acc[m][n] * rs, u = acc[m][n + 4] * rs; f32x4 a;
          a.x = g.x * __builtin_amdgcn_rcpf(1.f + __builtin_amdgcn_exp2f(-g.x * LOG2E)) * u.x;
          a.y = g.y * __builtin_amdgcn_rcpf(1.f + __builtin_amdgcn_exp2f(-g.y * LOG2E)) * u.y;
          a.z = g.z * __builtin_amdgcn_rcpf(1.f + __builtin_amdgcn_exp2f(-g.z * LOG2E)) * u.z;
          a.w = g.w * __builtin_amdgcn_rcpf(1.f + __builtin_amdgcn_exp2f(-g.w * LOG2E)) * u.w;
          store4(dst + 16 * n, a);
        }
      }
    }
    asm volatile("s_waitcnt vmcnt(0)" ::: "memory");
    __syncthreads();
    if (TID() == 0) {
      __builtin_amdgcn_fence(__ATOMIC_RELEASE, "agent");
      asm volatile("s_waitcnt vmcnt(0)" ::: "memory");
      (void)xb_add(&mq[128 + R], 1u); (void)xb_add(&mq[64], 1u);
    }
  });
  const int ncv1 = layer == 0 ? TJ1_DENSE / TJ_CHUNK : 0, ncv = layer == 0 ? (TJ1_DENSE + TJ1_GU) / TJ_CHUNK : 0, nitems = n8 + ncv;
  volatile LAS int* qs = (volatile LAS int*)(lds + LDS_MISC + 32);
  int all7 = 0, upto = 0;
  auto post = [&](unsigned nx_, unsigned d7v_, int slot) {
    const int nx = (int)__builtin_amdgcn_readfirstlane(nx_), d7v = (int)__builtin_amdgcn_readfirstlane(d7v_);
    if (!all7) {
      if (nx < n8) {
        int R, nt; tile_map(nx, totRT, 8, R, nt);
        if (R >= upto) {
          if (d7v == n7) all7 = 1;
          else {
            XB_SPIN(xb_ld(&mq[128 + R]) < 4u, barw);
            const int rr = upto + lane;
            const unsigned c = rr < totRT ? xb_ld(&mq[128 + rr]) : 0u;
            const unsigned long long okm = __builtin_amdgcn_ballot_w64(c >= 4u);
            const int pre = okm == ~0ull ? 64 : __builtin_ctzll(~okm);
            upto = upto + pre;
          }
          __builtin_amdgcn_fence(__ATOMIC_ACQUIRE, "agent");
        }
      } else if (nx >= n8 + ncv1 && nx < nitems) {
        XB_SPIN(xb_ld(&mq[64]) != (unsigned)n7, barw);
        all7 = 1;
        __builtin_amdgcn_fence(__ATOMIC_ACQUIRE, "agent");
      }
    }
    if (lane == 0) qs[slot] = nx;
  };
  auto prep8 = [&](int q, GemmS& g) { int R, nt; tile_map(q, totRT, 8, R, nt); const int e = moe_expert_of(mi, R);
    g.prep(lds, [&](int r) { return (const char*)(act2 + ((long)R * 256 + r) * 512); }, (const char*)(ws + W_DN) + (long)e * 2048 * 1024 + (long)nt * 256 * 64, 2048l * 64); };
  int par = 0;
  if (w == 0) { unsigned nx = 0u, dv = 0u; if (lane == 0) { nx = xb_add(&mq[0], 1u); dv = xb_ld(&mq[64]); } post(nx, dv, par); }
  __syncthreads();
  int q = qs[par];
  GemmS g;
  if (q < n8) prep8(q, g);
  while (q < n8) {
    unsigned nx = 0u, dv = 0u;
    if (TID() == 0) { nx = xb_add(&mq[0], 1u); if (!all7) dv = xb_ld(&mq[64]); }
    f32x4 acc[4][8];
    g.main(lds, 512, acc);
    par ^= 1;
    if (w == 0) post(nx, dv, par);
    __syncthreads();
    const int qn = qs[par];
    if (qn < n8) prep8(qn, g);
    {
      int R, nt; tile_map(q, totRT, 8, R, nt);
      const int e = moe_expert_of(mi, R), cnt = mi[17 + e], lrow0 = (R - mi[e]) * 256;
      asm volatile("" : "+v"(fr), "+v"(fq));
#pragma unroll
      for (int m = 0; m < 4; ++m) {
        const int lr = lrow0 + 64 * (w & 3) + 16 * m + fr;
        if (lr < cnt) {
          const unsigned ent = elist[e * 16384 + lr]; const unsigned tok = ent >> 1, slot = ent & 1u;
          const float gate = tokg[tok * 2 + slot];
          bf16_t* dst = yb + ((long)slot * NTOK + tok) * 2048 + nt * 256 + 128 * (w >> 2) + 4 * fq;
#pragma unroll
          for (int n = 0; n < 8; ++n) store4(dst + 16 * n, acc[m][n] * gate);
        }
      }
    }
    q = qn;
  }
  while (q < nitems) {
    unsigned nx = 0u;
    if (TID() == 0) nx = xb_add(&mq[0], 1u);
    const int j0 = (q - n8) * TJ_CHUNK;
    run_tjobs_blk<1>(p, lds, j0, j0 + TJ_CHUNK);
    par ^= 1;
    if (w == 0) post(nx, 0u, par);
    __syncthreads();
    q = qs[par];
  }
}

__device__ __forceinline__ void phase_router(PP p, LAS unsigned char* lds, int layer) {
  unsigned char* ws = p->ws;
  LAS float* wr = (LAS float*)lds;
  const int tid = TID(), lane = tid & 63, wave = tid >> 6;
  {
    const f32x4* wsrc = (const f32x4*)p->in[17];
    f32x4 tmp[16];
#pragma unroll
    for (int i = 0; i < 16; ++i) tmp[i] = wsrc[tid + 512 * i];
#pragma unroll
    for (int i = 0; i < 16; ++i) { const int idx = tid + 512 * i, d = idx >> 2, c4 = idx & 3;
      wr[(4 * c4 + 0) * 2048 + d] = tmp[i].x; wr[(4 * c4 + 1) * 2048 + d] = tmp[i].y; wr[(4 * c4 + 2) * 2048 + d] = tmp[i].z; wr[(4 * c4 + 3) * 2048 + d] = tmp[i].w; }
  }
  __syncthreads();
  LAS int* selE = (LAS int*)(lds + LDS_MISC + 256);
  LAS float* selG = (LAS float*)(lds + LDS_MISC + 768);
  const float* gvec = p->in[16] + layer * 2048;
  const float* rb = p->in[18];
  const bf16_t* hsrc = (const bf16_t*)(ws + PT_H);
  unsigned* cnt = (unsigned*)(ws + S_CTL) + CTL_ECNT + layer * 16 * 64;
  unsigned* elist = (unsigned*)(ws + S_ELIST);
  float* tokg = (float*)(ws + S_TOKG);
  const bool hb5 = (lane & 32) != 0, hb4 = (lane & 16) != 0, hb3 = (lane & 8) != 0, hb2 = (lane & 4) != 0;
  float* rstd = (float*)(ws + S_RSTD);
  auto finish = [&](float (&sacc)[16], int lrow) __attribute__((always_inline)) {
      float t8[8], t4[4], t2[2], t1;
#pragma unroll
      for (int k = 0; k < 8; ++k) { const float snd = hb5 ? sacc[k] : sacc[k + 8], kp = hb5 ? sacc[k + 8] : sacc[k]; t8[k] = kp + __shfl_xor(snd, 32); }
#pragma unroll
      for (int k = 0; k < 4; ++k) { const float snd = hb4 ? t8[k] : t8[k + 4], kp = hb4 ? t8[k + 4] : t8[k]; t4[k] = kp + __shfl_xor(snd, 16); }
#pragma unroll
      for (int k = 0; k < 2; ++k) { const float snd = hb3 ? t4[k] : t4[k + 2], kp = hb3 ? t4[k + 2] : t4[k]; t2[k] = kp + __shfl_xor(snd, 8); }
      { const float snd = hb2 ? t2[0] : t2[1], kp = hb2 ? t2[1] : t2[0]; t1 = kp + __shfl_xor(snd, 4); }
      t1 += __shfl_xor(t1, 2); t1 += __shfl_xor(t1, 1);
      float lg[16];
#pragma unroll
      for (int e = 0; e < 16; ++e) lg[e] = __uint_as_float(__builtin_amdgcn_readlane(__float_as_uint(t1), 32 * (e >> 3) + 16 * ((e >> 2) & 1) + 8 * ((e >> 1) & 1) + 4 * (e & 1)));
      float sc[16], bs[16];
#pragma unroll
      for (int e = 0; e < 16; ++e) { sc[e] = 1.f / (1.f + __expf(-lg[e])); bs[e] = sc[e] + rb[e]; }
      float bestGS = -3.0e38f, S1 = 0.f, S2 = 0.f; int E1 = 0, E2 = 1;
#pragma unroll
      for (int g = 0; g < 4; ++g) {
        const float b0 = bs[4 * g], b1 = bs[4 * g + 1], b2 = bs[4 * g + 2], b3 = bs[4 * g + 3];
        const float c0 = sc[4 * g], c1 = sc[4 * g + 1], c2 = sc[4 * g + 2], c3 = sc[4 * g + 3];
        int i1 = 0; float v1 = b0, s1 = c0;
        if (b1 > v1) { v1 = b1; i1 = 1; s1 = c1; } if (b2 > v1) { v1 = b2; i1 = 2; s1 = c2; } if (b3 > v1) { v1 = b3; i1 = 3; s1 = c3; }
        int i2 = -1; float v2 = -3.0e38f, s2 = 0.f;
        if (i1 != 0 && b0 > v2) { v2 = b0; i2 = 0; s2 = c0; } if (i1 != 1 && b1 > v2) { v2 = b1; i2 = 1; s2 = c1; }
        if (i1 != 2 && b2 > v2) { v2 = b2; i2 = 2; s2 = c2; } if (i1 != 3 && b3 > v2) { v2 = b3; i2 = 3; s2 = c3; }
        const float gs = v1 + v2;
        if (gs > bestGS) { bestGS = gs; E1 = 4 * g + i1; E2 = 4 * g + i2; S1 = s1; S2 = s2; }
      }
      if (lane == 0) { const float inv = 1.f / (S1 + S2); selE[lrow * 2] = E1; selE[lrow * 2 + 1] = E2; selG[lrow * 2] = S1 * inv; selG[lrow * 2 + 1] = S2 * inv; }
  };
  for (int chunk = blockIdx.x; chunk < NTOK / 64; chunk += gridDim.x) {
    u32x2 ha[8], hb[8];
    const long row0 = (long)chunk * 64 + wave * 8;
    load_yrow(hsrc + row0 * 2048, lane, ha); load_yrow(hsrc + (row0 + 1) * 2048, lane, hb);
#pragma unroll 1
    for (int i = 0; i < 8; i += 2) {
      const int lrow = wave * 8 + i; const long row = row0 + i;
      f32x4 va[8], vb[8];
      yrow_to_f32(ha, va); yrow_to_f32(hb, vb);
      if (i < 6) { load_yrow(hsrc + (row + 2) * 2048, lane, ha); load_yrow(hsrc + (row + 3) * 2048, lane, hb); }
      const float ra = norm_row(va, gvec, lane), rbv = norm_row(vb, gvec, lane);
      if (lane == 0) { rstd[row] = ra; rstd[row + 1] = rbv; }
      f32x2 tab[8][4];
      const LAS float* wlo = wr + 4 * lane; const LAS float* whi = wr + 8 * 2048 + 4 * lane;
      asm volatile("" : "+v"(wlo), "+v"(whi));
#pragma unroll
      for (int k = 0; k < 8; ++k) { tab[k][0] = (f32x2){va[k].x, vb[k].x}; tab[k][1] = (f32x2){va[k].y, vb[k].y}; tab[k][2] = (f32x2){va[k].z, vb[k].z}; tab[k][3] = (f32x2){va[k].w, vb[k].w}; }
      float sa[16], sb[16];
#pragma unroll
      for (int e = 0; e < 16; ++e) {
        f32x2 s0 = {0.f, 0.f}, s1 = {0.f, 0.f};
#pragma unroll
        for (int k = 0; k < 8; ++k) { const f32x4 wv = *(const LAS f32x4*)((e < 8 ? wlo : whi) + (e & 7) * 2048 + 256 * k);
          s0 += tab[k][0] * (f32x2){wv.x, wv.x}; s1 += tab[k][1] * (f32x2){wv.y, wv.y}; s0 += tab[k][2] * (f32x2){wv.z, wv.z}; s1 += tab[k][3] * (f32x2){wv.w, wv.w}; }
        s0 += s1;
        sa[e] = s0.x; sb[e] = s0.y;
        if ((e & 1) == 1) __builtin_amdgcn_sched_barrier(0);
      }
      finish(sa, lrow); finish(sb, lrow + 1);
    }
    __syncthreads();
    if (wave == 0) {
      const int e1 = selE[lane * 2], e2 = selE[lane * 2 + 1];
      const unsigned long long lt = (1ull << lane) - 1ull;
      unsigned pos1 = 0, pos2 = 0;
#pragma unroll
      for (int e = 0; e < 16; ++e) {
        const unsigned long long b0 = __ballot(e1 == e), b1 = __ballot(e2 == e);
        const unsigned n0 = __popcll(b0), tot = n0 + __popcll(b1);
        unsigned base = 0;
        if (tot) { if (lane == 0) base = atomicAdd(cnt + e * 64, tot); base = __builtin_amdgcn_readfirstlane(base); }
        if (e1 == e) pos1 = base + __popcll(b0 & lt);
        if (e2 == e) pos2 = base + n0 + __popcll(b1 & lt);
      }
      const unsigned tok = chunk * 64 + lane;
      elist[e1 * 16384 + pos1] = tok * 2u; elist[e2 * 16384 + pos2] = tok * 2u + 1u;
      tokg[tok * 2] = selG[lane * 2]; tokg[tok * 2 + 1] = selG[lane * 2 + 1];
    }
    __syncthreads();
  }
}

constexpr int AL_V = 0, AL_KN = 65536, AL_KR = 114688, AL_WS = 139264;
constexpr int AL_PF = 141312;
#define SBAR() __builtin_amdgcn_sched_barrier(0)
__device__ __forceinline__ int crow(int r, int hi) { return (r & 3) + 8 * (r >> 2) + 4 * hi; }
__device__ __forceinline__ int v_st(int k, int c) { const int kk = (k & ~0xC) | ((k & 4) << 1) | ((k & 8) >> 1); return ((kk >> 3) * 4 + (c >> 5)) * 512 + ((kk & 7) * 32 + (c & 31)) * 2; }
__device__ __forceinline__ int v_rd_base(int lane) { return ((lane & 3) << 3) | (((lane >> 2) & 3) << 6) | (((lane >> 4) & 1) << 5) | (((lane >> 5) & 1) << 8); }
constexpr int v_rd_off(int d0, int ks, int half) { return d0 * 512 + ks * 4096 + half * 2048; }
template <int OFF> __device__ __forceinline__ s16x4 tr_read(int vb) {
  s16x4 r; asm volatile("ds_read_b64_tr_b16 %0, %1 offset:%2" : "=&v"(r) : "v"(vb), "i"(OFF) : "memory"); return r;
}
template <int D0> __device__ __forceinline__ void pv_one(f32x16& od, int vb, bf16x8 pa0, bf16x8 pa1, bf16x8 pa2, bf16x8 pa3) {
  const s16x4 l0 = tr_read<v_rd_off(D0, 0, 0)>(vb), h0 = tr_read<v_rd_off(D0, 0, 1)>(vb), l1 = tr_read<v_rd_off(D0, 1, 0)>(vb), h1 = tr_read<v_rd_off(D0, 1, 1)>(vb);
  const s16x4 l2 = tr_read<v_rd_off(D0, 2, 0)>(vb), h2 = tr_read<v_rd_off(D0, 2, 1)>(vb), l3 = tr_read<v_rd_off(D0, 3, 0)>(vb), h3 = tr_read<v_rd_off(D0, 3, 1)>(vb);
  asm volatile("s_waitcnt lgkmcnt(0)" ::: "memory"); SBAR();
#define PKV(L, H) (bf16x8){L[0], L[1], L[2], L[3], H[0], H[1], H[2], H[3]}
  od = __builtin_amdgcn_mfma_f32_32x32x16_bf16(pa0, PKV(l0, h0), od, 0, 0, 0);
  od = __builtin_amdgcn_mfma_f32_32x32x16_bf16(pa1, PKV(l1, h1), od, 0, 0, 0);
  od = __builtin_amdgcn_mfma_f32_32x32x16_bf16(pa2, PKV(l2, h2), od, 0, 0, 0);
  od = __builtin_amdgcn_mfma_f32_32x32x16_bf16(pa3, PKV(l3, h3), od, 0, 0, 0);
#undef PKV
}
#define PK4(P, BASE, OUT) do { unsigned a0 = cvtpk(P[BASE + 0], P[BASE + 1]), a1 = cvtpk(P[BASE + 2], P[BASE + 3]);   \
    unsigned b0 = cvtpk(P[BASE + 4], P[BASE + 5]), b1 = cvtpk(P[BASE + 6], P[BASE + 7]);                              \
    auto r0 = __builtin_amdgcn_permlane32_swap(a0, b0, false, false); auto r1 = __builtin_amdgcn_permlane32_swap(a1, b1, false, false); \
    u32x4 w_ = {r0[0], r1[0], r0[1], r1[1]}; OUT = *reinterpret_cast<bf16x8*>(&w_); } while (0)

template <int DQK, bool MASK, bool BIAS>
__device__ __forceinline__ void attn_core(LAS unsigned char* lds, const bf16_t* qrow, const bf16_t* Kb, long kstride, const bf16_t* Vb, long vstride,
                                          int t0, int t1, int qi, int W, int qmin, int qmax, float C, float sl2, f32x16 (&o)[4], float& lsum) {
  const int tid = TID(), lane = tid & 63, r32 = lane & 31, hi = lane >> 5;
  constexpr int ND = DQK / 16;
  bf16x8 qr[ND];
#pragma unroll
  for (int d = 0; d < 4; ++d) o[d] = f32x16{};
  float ls = 0.f;
  const int w = __builtin_amdgcn_readfirstlane(tid >> 6);
  int koff[2], voff[2], roff = 0;
#pragma unroll
  for (int i = 0; i < 2; ++i) {
    const int s_ = (w * 2 + i) * 64 + lane;
    { const int row = s_ >> 4, c = (s_ & 15) ^ (row & 15); koff[i] = row * (int)kstride + c * 8; }
    { const int sub = s_ >> 5, kk = (sub >> 2) * 8 + ((s_ & 31) >> 2), k = (kk & ~0xC) | ((kk & 4) << 1) | ((kk & 8) >> 1), c = (sub & 3) * 32 + (s_ & 3) * 8; voff[i] = k * (int)vstride + c; }
  }
  if (DQK == 192) { const int s_ = w * 64 + lane, row = s_ >> 3, c = (s_ & 7) ^ ((row >> 1) & 7); roff = row * (int)kstride + 128 + c * 8; }
  const int kn_rd = r32 * 256, kn_x = (r32 & 15) << 4, kr_rd = r32 * 128, kr_x = (r32 >> 1) & 7;
  const int vb0 = (int)(unsigned long)(lds + AL_V) + v_rd_base(lane);
#define A_STAGE(t) do { const int i3_ = ((t) - t0) % 3, i4_ = ((t) - t0) & 3; const bf16_t* kt_ = Kb + (long)(t) * 64 * kstride; const bf16_t* vt_ = Vb + (long)(t) * 64 * vstride; \
    _Pragma("unroll") for (int i = 0; i < 2; ++i) { GLDS16(kt_ + koff[i], lds + AL_KN + i3_ * 16384 + (w * 2 + i) * 1024); GLDS16(vt_ + voff[i], lds + AL_V + i4_ * 16384 + (w * 2 + i) * 1024); } \
    if (DQK == 192) GLDS16(kt_ + roff, lds + AL_KR + i3_ * 8192 + w * 1024); } while (0)
  constexpr int NPT = (DQK == 192) ? 5 : 4;
  const bool lag = w >= 4;
  bf16x8 pp0, pp1, pp2, pp3; bool pend = false; int vprev = 0;
  if (t0 < t1) A_STAGE(t0);
  if (t0 + 1 < t1) A_STAGE(t0 + 1);
#pragma unroll
  for (int d0 = 0; d0 < ND; ++d0) qr[d0] = *(const bf16x8*)(qrow + d0 * 16 + hi * 8);
  for (int t = t0; t < t1; ++t) {
    if (t + 1 < t1) { if (NPT == 5) asm volatile("s_waitcnt vmcnt(5)" ::: "memory"); else asm volatile("s_waitcnt vmcnt(4)" ::: "memory"); }
    else asm volatile("s_waitcnt vmcnt(0)" ::: "memory");
    __builtin_amdgcn_s_barrier();
    asm volatile("" ::: "memory");
    if (t + 2 < t1) A_STAGE(t + 2);
    const int kbuf = (t - t0) % 3, vbuf = (t - t0) & 3;
    if (pend) { const int vb = vb0 + vprev * 16384;
      pv_one<0>(o[0], vb, pp0, pp1, pp2, pp3); pv_one<1>(o[1], vb, pp0, pp1, pp2, pp3); pv_one<2>(o[2], vb, pp0, pp1, pp2, pp3); pv_one<3>(o[3], vb, pp0, pp1, pp2, pp3); pend = false; }
    bool active = true, full = true;
    if (MASK) { active = (t * 64 <= qmax) && (t * 64 + 63 >= qmin - W); full = (t * 64 + 63 <= qmin) && (t * 64 >= qmax - W); }
    if (active) {
      f32x16 p0 = f32x16{}, p1 = f32x16{};
      const LAS unsigned char* kn = lds + AL_KN + kbuf * 16384 + kn_rd;
#pragma unroll
      for (int d0 = 0; d0 < 8; ++d0) {
        const int cb = (d0 * 32 + hi * 16) ^ kn_x;
        const bf16x8 b0 = *(const LAS bf16x8*)(kn + cb), b1 = *(const LAS bf16x8*)(kn + 8192 + cb);
        p0 = __builtin_amdgcn_mfma_f32_32x32x16_bf16(b0, qr[d0], p0, 0, 0, 0);
        p1 = __builtin_amdgcn_mfma_f32_32x32x16_bf16(b1, qr[d0], p1, 0, 0, 0);
      }
      if (DQK == 192) {
        const LAS unsigned char* kr = lds + AL_KR + kbuf * 8192 + kr_rd;
#pragma unroll
        for (int d0 = 8; d0 < ND; ++d0) {
          const int cb = ((2 * (d0 - 8) + hi) ^ kr_x) << 4;
          const bf16x8 b0 = *(const LAS bf16x8*)(kr + cb), b1 = *(const LAS bf16x8*)(kr + 4096 + cb);
          p0 = __builtin_amdgcn_mfma_f32_32x32x16_bf16(b0, qr[d0], p0, 0, 0, 0);
          p1 = __builtin_amdgcn_mfma_f32_32x32x16_bf16(b1, qr[d0], p1, 0, 0, 0);
        }
      }
      const float tb = BIAS ? sl2 * (float)(t * 64 + 4 * hi - qi) : 0.f;
      const int dd = qi - t * 64 - 4 * hi;
      if (!MASK || full) {
#pragma unroll
        for (int r = 0; r < 16; ++r) {
          const int c_r = (r & 3) + 8 * (r >> 2);
          const float x0 = fmaf(p0[r], C, BIAS ? fmaf(sl2, (float)c_r, tb) : 0.f), x1 = fmaf(p1[r], C, BIAS ? fmaf(sl2, (float)(c_r + 32), tb) : 0.f);
          p0[r] = __builtin_amdgcn_exp2f(x0); p1[r] = __builtin_amdgcn_exp2f(x1); ls += p0[r] + p1[r];
        }
      } else {
#pragma unroll
        for (int r = 0; r < 16; ++r) {
          const int c_r = (r & 3) + 8 * (r >> 2);
          float x0 = fmaf(p0[r], C, BIAS ? fmaf(sl2, (float)c_r, tb) : 0.f), x1 = fmaf(p1[r], C, BIAS ? fmaf(sl2, (float)(c_r + 32), tb) : 0.f);
          x0 = ((unsigned)(dd - c_r) <= (unsigned)W) ? x0 : -1.0e30f; x1 = ((unsigned)(dd - c_r - 32) <= (unsigned)W) ? x1 : -1.0e30f;
          p0[r] = __builtin_amdgcn_exp2f(x0); p1[r] = __builtin_amdgcn_exp2f(x1); ls += p0[r] + p1[r];
        }
      }
      PK4(p0, 0, pp0); PK4(p0, 8, pp1); PK4(p1, 0, pp2); PK4(p1, 8, pp3);
      if (lag) { pend = true; vprev = vbuf; }
      else { const int vb = vb0 + vbuf * 16384;
        pv_one<0>(o[0], vb, pp0, pp1, pp2, pp3); pv_one<1>(o[1], vb, pp0, pp1, pp2, pp3); pv_one<2>(o[2], vb, pp0, pp1, pp2, pp3); pv_one<3>(o[3], vb, pp0, pp1, pp2, pp3); }
    }
  }
  if (pend) { const int vb = vb0 + vprev * 16384;
    pv_one<0>(o[0], vb, pp0, pp1, pp2, pp3); pv_one<1>(o[1], vb, pp0, pp1, pp2, pp3); pv_one<2>(o[2], vb, pp0, pp1, pp2, pp3); pv_one<3>(o[3], vb, pp0, pp1, pp2, pp3); }
#undef A_STAGE
  { auto rr2 = __builtin_amdgcn_permlane32_swap(__float_as_uint(ls), __float_as_uint(ls), false, false);
    lsum = __uint_as_float(rr2[0]) + __uint_as_float(rr2[1]); }
}
__device__ __forceinline__ void attn_row_l(LAS float* wsc, float l, int r32, int hi, float (&lr)[16]) {
  if (hi == 0) wsc[r32] = l;
#pragma unroll
  for (int r = 0; r < 16; ++r) lr[r] = wsc[crow(r, hi)];
}

#define OPAQUE2(a, b) int a##_o = a, b##_o = b; asm volatile("" : "+v"(a##_o), "+v"(b##_o));
__device__ __forceinline__ bf16_t f2bf(float x) { return (bf16_t)(cvtpk(x, x) & 0xffffu); }
constexpr float C128 = 0.08838834764831845f * LOG2E, C192 = 0.07216878364870323f * LOG2E;

__device__ __forceinline__ void attn_item_mla(PP p, LAS unsigned char* lds, int b, int h, int qb) {
  unsigned char* ws = p->ws;
  const int tid = TID(), lane = tid & 63, w = __builtin_amdgcn_readfirstlane(tid >> 6), r32 = lane & 31, hi = lane >> 5;
  const int q0 = qb * 256 + 32 * w;
  const bf16_t* qrow = (const bf16_t*)(ws + PT_QB) + ((long)b * SEQ + q0 + r32) * 1536 + h * 192;
  const bf16_t* Kb = (const bf16_t*)(ws + PT_KB) + (long)b * SEQ * 1536 + h * 192;
  const bf16_t* Vb = (const bf16_t*)(ws + PT_VB) + (long)b * SEQ * 1024 + h * 128;
  f32x16 o[4]; float l;
  __syncthreads();
  attn_core<192, true, false>(lds, qrow, Kb, 1536, Vb, 1024, 0, (qb + 1) * 4, q0 + r32, 1 << 30, q0, q0 + 31, C192, 0.f, o, l);
  OPAQUE2(r32, hi);
  float lr[16]; attn_row_l((LAS float*)(lds + AL_WS + w * 256), l, r32_o, hi_o, lr);
  bf16_t* dst = (bf16_t*)(ws + ACT) + ((long)b * SEQ + q0) * 2048 + 1024 + h * 128 + r32_o;
#pragma unroll
  for (int r = 0; r < 16; ++r) {
    const float inv = 1.f / lr[r]; const long ro = (long)crow(r, hi_o) * 2048;
#pragma unroll
    for (int d0 = 0; d0 < 4; ++d0) dst[ro + d0 * 32] = f2bf(o[d0][r] * inv);
  }
}
__device__ __forceinline__ void attn_item_dil(PP p, LAS unsigned char* lds, int pat, int b, int h, int strm, int qb) {
  unsigned char* ws = p->ws;
  const int tid = TID(), lane = tid & 63, w = __builtin_amdgcn_readfirstlane(tid >> 6), r32 = lane & 31, hi = lane >> 5;
  const int dil = pat == 0 ? 1 : (pat == 1 ? 4 : 16);
  const int q0 = qb * 256 + 32 * w, qi = q0 + r32;
  const long tb = (long)b * SEQ + strm;
  const bf16_t* qrow = (const bf16_t*)(ws + P_QA) + (tb + (long)qi * dil) * 1024 + h * 128;
  const bf16_t* Kb = (const bf16_t*)(ws + P_KA) + tb * 1024 + h * 128;
  const bf16_t* Vb = (const bf16_t*)(ws + P_VA) + tb * 1024 + h * 128;
  const float sl2 = __builtin_amdgcn_exp2f(-(float)(h + 1)) * (float)dil * LOG2E;
  const int t0 = qb * 4 - 2 > 0 ? qb * 4 - 2 : 0;
  f32x16 o[4]; float l;
  __syncthreads();
  attn_core<128, true, true>(lds, qrow, Kb, (long)dil * 1024, Vb, (long)dil * 1024, t0, qb * 4 + 4, qi, 128, q0, q0 + 31, C128, sl2, o, l);
  OPAQUE2(r32, hi);
  if (pat != 0) {
    float* la = (float*)(ws + S_LA) + (long)(pat - 1) * NTOK * 8;
    bf16_t* pa = (bf16_t*)(ws + PT_PA) + (long)(pat - 1) * NTOK * 1024;
    if (hi_o == 0) la[(tb + (long)(q0 + r32_o) * dil) * 8 + h] = l;
#pragma unroll
    for (int r = 0; r < 16; ++r) {
      bf16_t* d = pa + (tb + (long)(q0 + crow(r, hi_o)) * dil) * 1024 + h * 128 + r32_o;
#pragma unroll
      for (int d0 = 0; d0 < 4; ++d0) d[d0 * 32] = f2bf(o[d0][r]);
    }
  } else {
    float lr[16]; attn_row_l((LAS float*)(lds + AL_WS + w * 256), l, r32_o, hi_o, lr);
    const float* la = (const float*)(ws + S_LA);
    const bf16_t* pa = (const bf16_t*)(ws + PT_PA);
    bf16_t* dst = (bf16_t*)(ws + ACT);
#pragma unroll
    for (int r = 0; r < 16; ++r) {
      const long tok = tb + q0 + crow(r, hi_o);
      const float lt = lr[r] + la[tok * 8 + h] + la[(long)NTOK * 8 + tok * 8 + h];
      const float inv = 1.f / lt;
      const bf16_t* p1 = pa + tok * 1024 + h * 128 + r32_o; const bf16_t* p2 = p1 + (long)NTOK * 1024;
#pragma unroll
      for (int d0 = 0; d0 < 4; ++d0) dst[tok * 2048 + h * 128 + d0 * 32 + r32_o] = f2bf((o[d0][r] + bf2f(p1[d0 * 32]) + bf2f(p2[d0 * 32])) * inv);
    }
  }
}
__device__ __forceinline__ int moba_list_off(int j) { return 256 * (31 * j - (j * (j - 1)) / 2); }
__device__ __forceinline__ void attn_item_moba_sel(PP p, LAS unsigned char* lds, int bh, int j, int chunk, int cnt) {
  unsigned char* ws = p->ws;
  const int tid = TID(), lane = tid & 63, w = __builtin_amdgcn_readfirstlane(tid >> 6), r32 = lane & 31, hi = lane >> 5;
  const int b = bh >> 4, h = bh & 15;
  const int idx = chunk * 256 + 32 * w + r32; const bool valid = idx < cnt;
  const unsigned ent = ((const unsigned*)(ws + S_MLIST))[(long)bh * 126976 + moba_list_off(j) + (valid ? idx : cnt - 1)];
  const int s = (int)(ent & 8191u), slot = (int)(ent >> 13);
  const long tokq = (long)b * SEQ + s;
  const bf16_t* qrow = (const bf16_t*)(ws + P_Q1) + tokq * 2048 + h * 128;
  const bf16_t* Kb = (const bf16_t*)(ws + P_K1) + (long)b * SEQ * 2048 + h * 128;
  const bf16_t* Vb = (const bf16_t*)(ws + P_V1) + (long)b * SEQ * 2048 + h * 128;
  const float sl2 = __builtin_amdgcn_exp2f(-0.5f * (float)(h + 1)) * LOG2E;
  f32x16 o[4]; float l;
  __syncthreads();
  attn_core<128, false, true>(lds, qrow, Kb, 2048, Vb, 2048, 4 * j, 4 * j + 4, s, 0, 0, 0, C128, sl2, o, l);
  OPAQUE2(r32, hi);
  LAS int* wsi = (LAS int*)(lds + AL_WS + w * 256) + 32;
  if (hi_o == 0) { wsi[r32_o] = valid ? (int)(tokq * 4 + slot) : -1; if (valid) ((float*)(ws + S_LSEL))[((long)slot * NTOK + tokq) * 16 + h] = l; }
  bf16_t* psel = (bf16_t*)(ws + PT_PSEL);
#pragma unroll
  for (int r = 0; r < 16; ++r) {
    const int info = wsi[crow(r, hi_o)];
    if (info >= 0) {
      bf16_t* d = psel + (((long)(info & 3) * NTOK + (info >> 2)) * 16 + h) * 128 + r32_o;
#pragma unroll
      for (int d0 = 0; d0 < 4; ++d0) d[d0 * 32] = f2bf(o[d0][r]);
    }
  }
}
__device__ __forceinline__ void attn_item_moba_own(PP p, LAS unsigned char* lds, int b, int h, int i) {
  unsigned char* ws = p->ws;
  const int tid = TID(), lane = tid & 63, w = __builtin_amdgcn_readfirstlane(tid >> 6), r32 = lane & 31, hi = lane >> 5;
  const int q0 = i * 256 + 32 * w, qi = q0 + r32;
  const bf16_t* qrow = (const bf16_t*)(ws + P_Q1) + ((long)b * SEQ + qi) * 2048 + h * 128;
  const bf16_t* Kb = (const bf16_t*)(ws + P_K1) + (long)b * SEQ * 2048 + h * 128;
  const bf16_t* Vb = (const bf16_t*)(ws + P_V1) + (long)b * SEQ * 2048 + h * 128;
  const float sl2 = __builtin_amdgcn_exp2f(-0.5f * (float)(h + 1)) * LOG2E;
  f32x16 o[4]; float l;
  __syncthreads();
  attn_core<128, true, true>(lds, qrow, Kb, 2048, Vb, 2048, 4 * i, 4 * i + 4, qi, 1 << 30, q0, q0 + 31, C128, sl2, o, l);
  OPAQUE2(r32, hi);
  float lr[16]; attn_row_l((LAS float*)(lds + AL_WS + w * 256), l, r32_o, hi_o, lr);
  const int nv = i < 3 ? i : 3;
  const float* lsel = (const float*)(ws + S_LSEL); const bf16_t* psel = (const bf16_t*)(ws + PT_PSEL);
  bf16_t* dst = (bf16_t*)(ws + ACT);
#pragma unroll
  for (int rg = 0; rg < 8; ++rg) {
    float lv[2][3]; unsigned short pv[2][3][4];
#pragma unroll
    for (int rr = 0; rr < 2; ++rr) {
      const long tok = (long)b * SEQ + q0 + crow(2 * rg + rr, hi_o);
#pragma unroll
      for (int sl = 0; sl < 3; ++sl) {
        const long ss = sl < nv ? sl : 0;
        lv[rr][sl] = lsel[(ss * NTOK + tok) * 16 + h];
        const bf16_t* ps = psel + ((ss * NTOK + tok) * 16 + h) * 128 + r32_o;
        pv[rr][sl][0] = ps[0]; pv[rr][sl][1] = ps[32]; pv[rr][sl][2] = ps[64]; pv[rr][sl][3] = ps[96];
      }
    }
#pragma unroll
    for (int rr = 0; rr < 2; ++rr) {
      const int r = 2 * rg + rr;
      const long tok = (long)b * SEQ + q0 + crow(r, hi_o);
      float lt = lr[r]; float a0 = o[0][r], a1 = o[1][r], a2 = o[2][r], a3 = o[3][r];
#pragma unroll
      for (int sl = 0; sl < 3; ++sl) {
        const bool on = sl < nv;
        lt += on ? lv[rr][sl] : 0.f;
        a0 += on ? bf2f(pv[rr][sl][0]) : 0.f; a1 += on ? bf2f(pv[rr][sl][1]) : 0.f; a2 += on ? bf2f(pv[rr][sl][2]) : 0.f; a3 += on ? bf2f(pv[rr][sl][3]) : 0.f;
      }
      const float inv = 1.f / lt; bf16_t* d = dst + tok * 2048 + h * 128 + r32_o;
      d[0] = f2bf(a0 * inv); d[32] = f2bf(a1 * inv); d[64] = f2bf(a2 * inv); d[96] = f2bf(a3 * inv);
    }
  }
}

__device__ __forceinline__ void phase_moba_gate(PP p, LAS unsigned char* lds) {
  unsigned char* ws = p->ws;
  LAS float* km = (LAS float*)lds;
  const int tid = TID(), lane = tid & 63;
  const float* kpart = (const float*)(ws + S_KPART);
  unsigned* mcnt = (unsigned*)(ws + S_CTL) + CTL_MCNT;
  unsigned* mlist = (unsigned*)(ws + S_MLIST);
  for (int k_ = blockIdx.x; k_ < 2 * 31 * 8; k_ += gridDim.x) {
    const int it = (gridDim.x == 256 && k_ >= 256) ? 751 - k_ : k_;
    const int b = it / 248, rem = it % 248, i = 1 + rem / 8, hp = rem % 8;
    __syncthreads();
    for (int idx = tid; idx < 2 * i * 128; idx += 512) {
      const int hh = idx / (i * 128), r2 = idx - hh * i * 128, j = r2 >> 7, d = r2 & 127, h = 2 * hp + hh;
      const float* kp = kpart + ((long)(b * 256 + 8 * j) * 16 + h) * 128 + d;
      float s = 0.f;
#pragma unroll
      for (int c = 0; c < 8; ++c) s += kp[c * 16 * 128];
      km[(hh * 32 + j) * 128 + d] = s * (1.f / 256.f);
    }
    __syncthreads();
    const int q = tid & 255, hh = tid >> 8, h = 2 * hp + hh, bh = b * 16 + h;
    const bf16_t* qp = (const bf16_t*)(ws + P_Q1) + ((long)b * SEQ + i * 256 + q) * 2048 + h * 128;
    float qf[128];
#pragma unroll
    for (int c = 0; c < 16; ++c) {
      const u32x4 u = *(const u32x4*)(qp + 8 * c);
      qf[8 * c + 0] = bflo(u.x); qf[8 * c + 1] = bfhi(u.x); qf[8 * c + 2] = bflo(u.y); qf[8 * c + 3] = bfhi(u.y);
      qf[8 * c + 4] = bflo(u.z); qf[8 * c + 5] = bfhi(u.z); qf[8 * c + 6] = bflo(u.w); qf[8 * c + 7] = bfhi(u.w);
    }
    float v0 = -3.0e38f, v1 = -3.0e38f, v2 = -3.0e38f; int i0 = 0, i1 = 0, i2 = 0;
    for (int j = 0; j < i; ++j) {
      const LAS float* kj = km + (hh * 32 + j) * 128;
      float g0 = 0.f, g1 = 0.f, g2 = 0.f, g3 = 0.f;
#pragma unroll
      for (int d4 = 0; d4 < 32; ++d4) { const f32x4 kv = *(const LAS f32x4*)(kj + 4 * d4); g0 = fmaf(qf[4 * d4], kv.x, g0); g1 = fmaf(qf[4 * d4 + 1], kv.y, g1); g2 = fmaf(qf[4 * d4 + 2], kv.z, g2); g3 = fmaf(qf[4 * d4 + 3], kv.w, g3); }
      const float g = (g0 + g1) + (g2 + g3);
      if (g > v0) { v2 = v1; i2 = i1; v1 = v0; i1 = i0; v0 = g; i0 = j; }
      else if (g > v1) { v2 = v1; i2 = i1; v1 = g; i1 = j; }
      else if (g > v2) { v2 = g; i2 = j; }
    }
    const int nv = i < 3 ? i : 3;
    const unsigned qs = (unsigned)(i * 256 + q);
    const unsigned long long lt = (1ull << lane) - 1ull;
    unsigned my_tot = 0;
    for (int j = 0; j < i; ++j) {
      const unsigned tot = __popcll(__ballot(i0 == j)) + __popcll(__ballot(nv > 1 && i1 == j)) + __popcll(__ballot(nv > 2 && i2 == j));
      if (lane == j) my_tot = tot;
    }
    unsigned my_base = 0;
    if (my_tot) my_base = atomicAdd(mcnt + bh * 32 + lane, my_tot);
    for (int j = 0; j < i; ++j) {
      const unsigned long long m0 = __ballot(i0 == j), m1 = __ballot(nv > 1 && i1 == j), m2 = __ballot(nv > 2 && i2 == j);
      const unsigned n0 = __popcll(m0), n1 = __popcll(m1);
      if ((m0 | m1 | m2) == 0ull) continue;
      const unsigned base = __builtin_amdgcn_readlane(my_base, j);
      unsigned* L = mlist + (long)bh * 126976 + moba_list_off(j) + base;
      if (i0 == j) L[__popcll(m0 & lt)] = qs;
      if (nv > 1 && i1 == j) L[n0 + __popcll(m1 & lt)] = qs | (1u << 13);
      if (nv > 2 && i2 == j) L[n0 + n1 + __popcll(m2 & lt)] = qs | (2u << 13);
    }
  }
}
__device__ __forceinline__ void phase_moba_sel(PP p, LAS unsigned char* lds) {
  const int tid = TID(), lane = tid & 63, wave = tid >> 6;
  LAS int* pf = (LAS int*)(lds + AL_PF);
  LAS int* wt = pf + 1032;
  const unsigned* mcnt = (const unsigned*)(p->ws + S_CTL) + CTL_MCNT;
  const int a = ((int)mcnt[2 * tid] + 255) >> 8, b2 = ((int)mcnt[2 * tid + 1] + 255) >> 8, s = a + b2;
  int v = s;
#pragma unroll
  for (int o = 1; o < 64; o <<= 1) { const int t = __shfl_up(v, o); if (lane >= o) v += t; }
  if (lane == 63) wt[wave] = v;
  __syncthreads();
  int woff = 0;
  for (int k = 0; k < wave; ++k) woff += wt[k];
  const int excl = woff + v - s;
  pf[2 * tid] = excl; pf[2 * tid + 1] = excl + a;
  if (tid == 511) pf[1024] = excl + s;
  __syncthreads();
  const int total = pf[1024];
  for (int it = blockIdx.x; it < total; it += gridDim.x) {
    int lo = 0, hi = 1024;
    while (hi - lo > 1) { const int mid = (lo + hi) >> 1; if (pf[mid] <= it) lo = mid; else hi = mid; }
    attn_item_moba_sel(p, lds, lo >> 5, lo & 31, it - pf[lo], (int)mcnt[lo]);
  }
}

__device__ __forceinline__ void phase_prep0(PP p, LAS unsigned char* lds) {
  unsigned char* ws = p->ws;
  const int tid = TID(), lane = tid & 63, wave = tid >> 6;
  run_tjobs<0>(p, lds, 0, TJ0_DENSE, 0);
  const long gt = (long)blockIdx.x * 512 + tid, GT = (long)gridDim.x * 512;
  { for (long i = gt; i < 64 * 192 * 4; i += GT) { const long c = i / (192 * 4), r = i % (192 * 4); *(u32x4*)((bf16_t*)(ws + W0_IN) + (c * 4096 + 3904) * 32 + r * 8) = (u32x4){0u, 0u, 0u, 0u}; } }
  { float* rope = (float*)(ws + S_ROPE);
    for (long i = gt; i < 8192 * 32; i += GT) {
      const int pos = (int)(i >> 5), f = (int)(i & 31);
      const double rev = (double)pos * (double)p->inv_freq[f] * 0.15915494309189535;
      const float fr = (float)(rev - floor(rev));
      rope[2 * i] = __builtin_amdgcn_cosf(fr); rope[2 * i + 1] = __builtin_amdgcn_sinf(fr);
    } }
  {
    const long rs = (long)gridDim.x * 8; long row = (long)blockIdx.x * 8 + wave;
    f32x4 v[8], vn[8];
    if (row < NTOK) load_row(p->in[0] + row * 2048, lane, v);
    for (; row < NTOK; row += rs) {
      if (row + rs < NTOK) load_row(p->in[0] + (row + rs) * 2048, lane, vn);
      norm_row(v, p->in[1], lane); store_row_bf16((bf16_t*)(ws + ACT) + row * 2048, lane, v);
#pragma unroll
      for (int i = 0; i < 8; ++i) v[i] = vn[i];
    }
  }
}
__device__ __forceinline__ void phase_prep1(PP p, LAS unsigned char* lds) {
  unsigned char* ws = p->ws;
  const int tid = TID(), lane = tid & 63, wave = tid >> 6;
  run_tjobs<1>(p, lds, TJ1_DENSE + TJ1_GU, TJ1_TOTAL, 0);
  const bf16_t* yb = (const bf16_t*)(ws + P_YB);
  {
    const long rs = (long)gridDim.x * 8; long row = (long)blockIdx.x * 8 + wave;
    const bf16_t* hsrc = (const bf16_t*)(ws + PT_H);
    f32x4 v[8]; u32x2 hw[8], hwn[8]; u32x2 y0[8], y1[8], y0n[8], y1n[8];
    if (row < NTOK) { load_yrow(hsrc + row * 2048, lane, hw); load_yrow(yb + row * 2048, lane, y0); load_yrow(yb + ((long)NTOK + row) * 2048, lane, y1); }
    for (; row < NTOK; row += rs) {
      const long rn = row + rs;
      if (rn < NTOK) { load_yrow(hsrc + rn * 2048, lane, hwn); load_yrow(yb + rn * 2048, lane, y0n); load_yrow(yb + ((long)NTOK + rn) * 2048, lane, y1n); }
      yrow_to_f32(hw, v); add_yrow(y0, v); add_yrow(y1, v);
      { float ss = 0.f;
#pragma unroll
        for (int i = 0; i < 8; ++i) ss += (v[i].x * v[i].x + v[i].y * v[i].y) + (v[i].z * v[i].z + v[i].w * v[i].w);
        ss = wave_sum(ss);
        if (lane == 0) ((float*)(ws + S_RSTD))[row] = rsqrtf(ss * (1.f / DM) + EPS); }
      store_row_bf16((bf16_t*)p->out + row * 2048, lane, v);
#pragma unroll
      for (int i = 0; i < 8; ++i) { hw[i] = hwn[i]; y0[i] = y0n[i]; y1[i] = y1n[i]; }
    }
  }
}
__device__ __forceinline__ void phase_final(PP p) {
  const int lane = TID() & 63, wave = TID() >> 6;
  const bf16_t* yb = (const bf16_t*)(p->ws + P_YB);
  const long rs = (long)gridDim.x * 8; long row = (long)blockIdx.x * 8 + wave;
  const bf16_t* hsrc = (const bf16_t*)(p->ws + PT_H);
  f32x4 v[8]; u32x2 hw[8], hwn[8]; u32x2 y0[8], y1[8], y0n[8], y1n[8];
  if (row < NTOK) { load_yrow(hsrc + row * 2048, lane, hw); load_yrow(yb + row * 2048, lane, y0); load_yrow(yb + ((long)NTOK + row) * 2048, lane, y1); }
  for (; row < NTOK; row += rs) {
    const long rn = row + rs;
    if (rn < NTOK) { load_yrow(hsrc + rn * 2048, lane, hwn); load_yrow(yb + rn * 2048, lane, y0n); load_yrow(yb + ((long)NTOK + rn) * 2048, lane, y1n); }
    yrow_to_f32(hw, v); add_yrow(y0, v); add_yrow(y1, v);
    store_row_f32(p->out + row * 2048, lane, v);
#pragma unroll
    for (int i = 0; i < 8; ++i) { hw[i] = hwn[i]; y0[i] = y0n[i]; y1[i] = y1n[i]; }
  }
}

__device__ __forceinline__ void phase_attn0_mla(PP p, LAS unsigned char* lds) {
  for (int k = blockIdx.x; k < 512; k += gridDim.x) { const int s = k < 256 ? k : 767 - k, qb = 31 - s / 16, bh = s % 16; attn_item_mla(p, lds, bh >> 3, bh & 7, qb);
    if (k == (int)blockIdx.x) {
      __syncthreads();
      run_tjobs<0>(p, lds, TJ0_DENSE, TJ0_TOTAL, 0);
      __syncthreads();
    } }
}
__device__ __forceinline__ void phase_attn0_dil(PP p, LAS unsigned char* lds, int first) {
  if (first) { for (int k = blockIdx.x; k < 1024; k += gridDim.x) { const int pat = 1 + k / 512, kk = k % 512, nqb = pat == 1 ? 8 : 2, i32 = kk % 32;
      attn_item_dil(p, lds, pat, kk / 256, (kk / 32) % 8, i32 / nqb, i32 % nqb); } }
  else { for (int k = blockIdx.x; k < 512; k += gridDim.x) attn_item_dil(p, lds, 0, k / 256, (k / 32) % 8, 0, k % 32); }
}
__device__ __forceinline__ void phase_moba_own(PP p, LAS unsigned char* lds) {
  for (int k = blockIdx.x; k < 1024; k += gridDim.x) attn_item_moba_own(p, lds, k / 512, (k / 32) % 16, k % 32);
}
__global__ void __launch_bounds__(512) mega(Params p_arg) {
  PP p = (PP)__builtin_amdgcn_kernarg_segment_ptr();
  extern __shared__ __attribute__((aligned(16))) unsigned char lds_raw[];
  LAS unsigned char* lds = (LAS unsigned char*)lds_raw;
  const int tid = TID();
  if (tid < 4) ((LAS unsigned*)(lds + LDS_MISC))[tid] = 0u;
  __syncthreads();
  XcdBarrier bar; bar.bar = (unsigned*)(p->ws + S_CTL) + CTL_BAR; bar.x = 0; bar.st = (volatile LAS unsigned*)(lds + LDS_MISC);
  if (p->ph_hi - p->ph_lo > 1) bar = xcd_barrier_post((unsigned*)(p->ws + S_CTL) + CTL_BAR, (volatile LAS unsigned*)(lds + LDS_MISC));
  const int lo = p->ph_lo, hi = p->ph_hi;
#ifndef ONLY_PH
#define ONLY_PH -1
#endif
#define IN(k) ((ONLY_PH < 0 || ONLY_PH == (k)) && lo <= (k) && (k) < hi)
#define SEAM(k) do { if ((k) + 1 < hi) xcd_barrier(bar); } while (0)
#define RUN(k, call) do { const int n_ = (p->rep_ph == (k)) ? 2 : 1; for (int r_ = 0; r_ < n_; ++r_) { call; } } while (0)
  if (IN(0)) { RUN(0, phase_prep0(p, lds)); SEAM(0); }
  if (IN(1)) { RUN(1, phase_inproj(p, lds)); SEAM(1); }
  if (IN(2)) { RUN(2, phase_qkvb(p, lds)); SEAM(2); }
  if (IN(3)) { RUN(3, phase_attn0_mla(p, lds)); RUN(30, phase_attn0_dil(p, lds, 1)); SEAM(3); }
  if (IN(4)) { RUN(4, phase_attn0_dil(p, lds, 0)); SEAM(4); }
  if (IN(5)) { RUN(5, phase_outproj<false>(p, lds, (const char*)(p->ws + W0_O), p->in[0], (bf16_t*)(p->ws + PT_H))); SEAM(5); }
  if (IN(6)) { phase_router(p, lds, 0); SEAM(6); }
  if (IN(7)) { phase_moe(p, lds, 0); }
  if (IN(8)) { SEAM(8); }
  if (IN(9)) { RUN(9, phase_prep1(p, lds)); SEAM(9); }
  if (IN(10)) { RUN(10, phase_qkv1(p, lds)); SEAM(10); }
  if (IN(11)) { phase_moba_gate(p, lds); SEAM(11); }
  if (IN(12)) { RUN(12, phase_moba_sel(p, lds)); SEAM(12); }
  if (IN(13)) { RUN(13, phase_moba_own(p, lds)); SEAM(13); }
  if (IN(14)) { RUN(14, phase_outproj<true>(p, lds, (const char*)(p->ws + W1_O), p->out, (bf16_t*)(p->ws + PT_H))); SEAM(14); }
  if (IN(15)) { phase_router(p, lds, 1); SEAM(15); }
  if (IN(16)) { phase_moe(p, lds, 1); }
  if (IN(17)) { SEAM(17); }
  if (IN(18)) { RUN(18, phase_final(p)); }
#undef RUN
#undef IN
#undef SEAM
}

extern "C" void kernel_launch(void* const* d_in, const int* in_sizes, int n_in, void* d_out, int out_size, void* d_ws, size_t ws_size, hipStream_t stream) {
  static int grid = 0;
  if (grid == 0) {
    if (n_in != 22 || in_sizes[0] != NTOK * DM || out_size != NTOK * DM || ws_size < WS_END) {
      fprintf(stderr, "kernel_launch: shape/workspace mismatch: n_in %d in0 %d out %d ws %zu (need %zu)\n", n_in, n_in > 0 ? in_sizes[0] : -1, out_size, ws_size, (size_t)WS_END);
      grid = -1; return; }
    int dev = 0, cus = 0, per_cu = 0;
    if (hipGetDevice(&dev) != hipSuccess || hipDeviceGetAttribute(&cus, hipDeviceAttributeMultiprocessorCount, dev) != hipSuccess) { grid = -1; return; }
    if (hipFuncSetAttribute((const void*)mega, hipFuncAttributeMaxDynamicSharedMemorySize, LDS_BYTES) != hipSuccess) { fprintf(stderr, "kernel_launch: hipFuncSetAttribute failed\n"); grid = -1; return; }
    if (hipOccupancyMaxActiveBlocksPerMultiprocessor(&per_cu, (const void*)mega, 512, LDS_BYTES) != hipSuccess || per_cu < 1) { fprintf(stderr, "kernel_launch: occupancy query says %d\n", per_cu); (void)hipGetLastError(); grid = -1; return; }
    grid = cus;
  }
  if (grid < 0) return;
  (void)hipMemsetAsync((char*)d_ws + S_CTL, 0, (size_t)CTL_WORDS * 4, stream);
  Params p{};
  for (int i = 0; i < 22; ++i) p.in[i] = (const float*)d_in[i];
  p.out = (float*)d_out; p.ws = (unsigned char*)d_ws; p.rep_ph = REP_PH;
  for (int i = 0; i < 32; ++i) p.inv_freq[i] = (float)std::pow(10000.0, -(double)(2 * i) / 64.0);
#if MK_SINGLE
  p.ph_lo = 0; p.ph_hi = NPH;
  void* args[] = {&p};
  hipError_t e = hipLaunchCooperativeKernel((const void*)mega, dim3(grid), dim3(512), args, LDS_BYTES, stream);
  if (e != hipSuccess) fprintf(stderr, "kernel_launch: cooperative launch failed: %s (grid %d)\n", hipGetErrorString(e), grid);
#else
  for (int ph = 0; ph < NPH; ++ph) {
    p.ph_lo = ph; p.ph_hi = ph + 1;
    hipLaunchKernelGGL(mega, dim3(grid), dim3(512), LDS_BYTES, stream, p);
  }
#endif
}
```
